# Optimizing an MI355X kernel written in HIP

```python
import math
import jax, jax.numpy as jnp
from jax import lax
import numpy as np

D_MODEL = 1024
BATCH = 16
SEQ = 2048
DEPTH = 1

CHUNK = 64
N_MEM = 256
D_CONV = D_MODEL
CONV_WIDTH = 3
FOX_HEAD_DIM = 128
FOX_HEADS = D_MODEL // FOX_HEAD_DIM
FOX_WIDTH = FOX_HEADS * FOX_HEAD_DIM
XA_HEADS = 4
XA_HEAD_DIM = D_MODEL // XA_HEADS
XA_WIDTH = XA_HEADS * XA_HEAD_DIM
N_BRANCH = 3
D_FF = -(-8 * D_MODEL // (3 * 256)) * 256
Q_BLOCK = 128
EPS = 1e-6
IN_SPLITS = (D_CONV, D_CONV, D_CONV, FOX_WIDTH, FOX_WIDTH, FOX_WIDTH, XA_WIDTH,
             D_MODEL, D_MODEL, D_MODEL, FOX_HEADS)
IN_COLS = sum(IN_SPLITS)

kernel_name = "hybrid_conv_fox_memory_block"


def rms_norm(x, g):
    xf = x.astype(jnp.float32)
    y = xf * lax.rsqrt(jnp.mean(xf * xf, axis=-1, keepdims=True) + EPS)
    return (y * g.astype(jnp.float32)).astype(x.dtype)


def split_cols(z):
    outs, off = [], 0
    for w in IN_SPLITS:
        outs.append(z[..., off:off + w])
        off += w
    return outs


def short_gated_conv(b_gate, c_gate, v, conv_w, conv_b):
    u = c_gate * v
    rhs = conv_w[:, None, :]
    y = lax.conv_general_dilated(u, rhs, window_strides=(1,),
                                 padding=[(CONV_WIDTH - 1, 0)],
                                 dimension_numbers=('NWC', 'WIO', 'NWC'),
                                 feature_group_count=D_CONV)
    return b_gate * (y + conv_b)


def forgetting_attention(q, k, v, log_f):
    b, s, h, hd = q.shape
    nb = s // Q_BLOCK
    c = jnp.cumsum(log_f, axis=1).transpose(0, 2, 1)
    kh = k.transpose(0, 2, 1, 3)
    vh = v.transpose(0, 2, 1, 3)
    q_blocks = q.transpose(0, 2, 1, 3).reshape(b, h, nb, Q_BLOCK, hd).transpose(2, 0, 1, 3, 4)
    c_blocks = c.reshape(b, h, nb, Q_BLOCK).transpose(2, 0, 1, 3)
    k_pos = jnp.arange(s)
    scale = 1.0 / math.sqrt(hd)

    def block(args):
        qb, cb, i = args
        logits = jnp.einsum('bhqd,bhkd->bhqk', qb, kh,
                            preferred_element_type=jnp.float32) * scale
        logits = logits + cb[..., None] - c[:, :, None, :]
        q_pos = i * Q_BLOCK + jnp.arange(Q_BLOCK)
        mask = q_pos[:, None] >= k_pos[None, :]
        logits = jnp.where(mask, logits, -jnp.inf)
        p = jax.nn.softmax(logits, axis=-1).astype(vh.dtype)
        return jnp.einsum('bhqk,bhkd->bhqd', p, vh)

    out = lax.map(block, (q_blocks, c_blocks, jnp.arange(nb)))
    return out.transpose(1, 0, 3, 2, 4).reshape(b, s, h * hd)


def memory_cross_attention(q, mem_n, w_mem_kv, q_g, k_g):
    b, s = q.shape[0], q.shape[1]
    kv = mem_n @ w_mem_kv
    k = kv[..., :XA_WIDTH].reshape(b, -1, XA_HEADS, XA_HEAD_DIM)
    v = kv[..., XA_WIDTH:].reshape(b, -1, XA_HEADS, XA_HEAD_DIM)
    q = rms_norm(q, q_g)
    k = rms_norm(k, k_g)
    logits = jnp.einsum('bshd,bmhd->bhsm', q, k,
                        preferred_element_type=jnp.float32) / math.sqrt(XA_HEAD_DIM)
    p = jax.nn.softmax(logits, axis=-1).astype(v.dtype)
    return jnp.einsum('bhsm,bmhd->bshd', p, v).reshape(b, s, XA_WIDTH)


def setup_inputs(seed: int = 0) -> dict:
    key = jax.random.key(seed)
    ks = jax.random.split(key, 24)
    f32 = jnp.float32
    nrm = lambda k, shape, fan: jax.random.normal(k, shape, f32) * fan ** -0.5
    gain = lambda k, shape: 1.0 + 0.02 * jax.random.normal(k, shape, f32)
    L = DEPTH
    return {
        "x": jax.random.normal(ks[0], (BATCH, SEQ, D_MODEL), f32),
        "mem": jax.random.normal(ks[1], (BATCH, N_MEM, D_MODEL), f32),
        "norm1_g": gain(ks[2], (L, D_MODEL)),
        "w_in": nrm(ks[3], (L, D_MODEL, IN_COLS), D_MODEL),
        "conv_w": nrm(ks[4], (L, CONV_WIDTH, D_CONV), CONV_WIDTH),
        "conv_b": 0.02 * jax.random.normal(ks[5], (L, D_CONV), f32),
        "fox_f_bias": 2.0 + 2.0 * jax.random.uniform(ks[6], (L, FOX_HEADS), f32),
        "fox_q_g": gain(ks[7], (L, FOX_HEAD_DIM)),
        "fox_k_g": gain(ks[8], (L, FOX_HEAD_DIM)),
        "mem_norm_g": gain(ks[9], (L, D_MODEL)),
        "w_mem_kv": nrm(ks[10], (L, D_MODEL, 2 * XA_WIDTH), D_MODEL),
        "xa_q_g": gain(ks[11], (L, XA_HEAD_DIM)),
        "xa_k_g": gain(ks[12], (L, XA_HEAD_DIM)),
        "w_br_conv": nrm(ks[13], (L, D_CONV, D_MODEL), D_CONV),
        "w_br_fox": nrm(ks[14], (L, FOX_WIDTH, D_MODEL), FOX_WIDTH),
        "w_br_xa": nrm(ks[15], (L, XA_WIDTH, D_MODEL), XA_WIDTH),
        "w_o": nrm(ks[16], (L, D_MODEL, D_MODEL), D_MODEL),
        "norm2_g": gain(ks[17], (L, D_MODEL)),
        "w_ffn_in": nrm(ks[18], (L, D_MODEL, 2 * D_FF), D_MODEL),
        "w_ffn_out": nrm(ks[19], (L, D_FF, D_MODEL), D_FF),
    }


def reference(x, mem, norm1_g, w_in, conv_w, conv_b, fox_f_bias, fox_q_g, fox_k_g,
              mem_norm_g, w_mem_kv, xa_q_g, xa_k_g, w_br_conv, w_br_fox, w_br_xa,
              w_o, norm2_g, w_ffn_in, w_ffn_out):
    b, s, _ = x.shape
    for l in range(DEPTH):
        h = rms_norm(x, norm1_g[l])
        z = h @ w_in[l]
        (cb, cc, cv, fq, fk, fv, xq, ga, gb, gc, ff) = split_cols(z)

        y_conv = short_gated_conv(cb, cc, cv, conv_w[l], conv_b[l])

        fq = rms_norm(fq.reshape(b, s, FOX_HEADS, FOX_HEAD_DIM), fox_q_g[l])
        fk = rms_norm(fk.reshape(b, s, FOX_HEADS, FOX_HEAD_DIM), fox_k_g[l])
        fv = fv.reshape(b, s, FOX_HEADS, FOX_HEAD_DIM)
        log_f = jax.nn.log_sigmoid(ff.astype(jnp.float32) + fox_f_bias[l].astype(jnp.float32))
        y_fox = forgetting_attention(fq, fk, fv, log_f)

        mem_n = rms_norm(mem, mem_norm_g[l])
        y_xa = memory_cross_attention(xq.reshape(b, s, XA_HEADS, XA_HEAD_DIM), mem_n,
                                      w_mem_kv[l], xa_q_g[l], xa_k_g[l])

        merged = (jax.nn.sigmoid(ga) * (y_conv @ w_br_conv[l])
                  + jax.nn.sigmoid(gb) * (y_fox @ w_br_fox[l])
                  + jax.nn.sigmoid(gc) * (y_xa @ w_br_xa[l]))
        x = x + merged @ w_o[l]

        h2 = rms_norm(x, norm2_g[l])
        gu = h2 @ w_ffn_in[l]
        x = x + (jax.nn.silu(gu[..., :D_FF]) * gu[..., D_FF:]) @ w_ffn_out[l]
    return x
```

```cpp
#include <hip/hip_runtime.h>
#include <hip/hip_cooperative_groups.h>
#include <cstdint>
#include <cstdio>
namespace cg = cooperative_groups;

#define LAS __attribute__((address_space(3)))
#define GAS __attribute__((address_space(1)))
typedef unsigned short bf16_t;
typedef short bf16x8 __attribute__((ext_vector_type(8)));
typedef float f32x4 __attribute__((ext_vector_type(4)));
typedef float f32x16 __attribute__((ext_vector_type(16)));
typedef unsigned u32x4 __attribute__((ext_vector_type(4)));
typedef unsigned u32x2 __attribute__((ext_vector_type(2)));

constexpr int T = 32768, D = 1024, SEQ = 2048, NBATCH = 16, NCH = 2, BC = 8, TC = BC * SEQ;
constexpr int NH = 8, HD = 128, NMEM = 256, DFF = 2816, INCOLS = 10248;
constexpr float EPS = 1e-6f, LOG2E = 1.4426950408889634f;
constexpr int NZT = 36;
constexpr size_t MiB = 1u << 20;
constexpr size_t WS_WZ = 0, WS_WV = 18 * MiB, WS_WKK = 20 * MiB, WS_WKV = 22 * MiB, WS_WBR = 24 * MiB, WS_WO = 30 * MiB, WS_WFI = 32 * MiB, WS_WFO = 43 * MiB;
constexpr size_t WS_SMALL = 49 * MiB, WS_LOGF = 50 * MiB, WS_C2 = 51 * MiB, WS_H = 52 * MiB, WS_MEMN = 116 * MiB, WS_KMEM = 124 * MiB, WS_VTMEM = 132 * MiB;
constexpr size_t WS_SSQQ = 140 * MiB, WS_SSQK = 142 * MiB, WS_SSQX = 144 * MiB, WS_SSQKM = 145 * MiB, WS_LSUM = 146 * MiB, WS_SSQ2 = 147 * MiB;
constexpr size_t WS_CB = 152 * MiB, WS_U = 184 * MiB, WS_FQ = 216 * MiB, WS_FK = 248 * MiB, WS_VT = 280 * MiB, WS_XQ = 312 * MiB, WS_GATES = 344 * MiB, WS_P = 440 * MiB;
constexpr size_t WS_X1B = 152 * MiB, WS_ACT = 216 * MiB, WS_END = 472 * MiB;
constexpr int LDS_BYTES = 131072;
constexpr size_t WS_BAR = WS_SMALL + 65536;

typedef float f32x2_t __attribute__((ext_vector_type(2)));
typedef __bf16 bf16x2_t __attribute__((ext_vector_type(2)));
__device__ __forceinline__ unsigned cvt_pk(float lo, float hi) { f32x2_t v = {lo, hi}; bf16x2_t b = __builtin_convertvector(v, bf16x2_t); return __builtin_bit_cast(unsigned, b); }
__device__ __forceinline__ float bflo(unsigned u) { return __builtin_bit_cast(float, u << 16); }
__device__ __forceinline__ float bfhi(unsigned u) { return __builtin_bit_cast(float, u & 0xffff0000u); }
__device__ __forceinline__ float wave_sum(float v) {
#pragma unroll
    for (int o = 1; o < 64; o <<= 1) v += __shfl_xor(v, o);
    return v;
}
__device__ __forceinline__ float fexp2(float x) { return __builtin_amdgcn_exp2f(x); }
__device__ __forceinline__ float frcp(float x) { return __builtin_amdgcn_rcpf(x); }
__device__ __forceinline__ float sigmoidf_(float v) { return frcp(1.f + fexp2(-v * LOG2E)); }
#define LDS_WAIT() asm volatile("s_waitcnt lgkmcnt(0)" ::: "memory")

namespace pg8 {
constexpr int BM = 256, BK = 64, HALF = 128, HTB = HALF * BK * 2, STAGE_BYTES = 8 * HTB;
__device__ __forceinline__ int lds_byte(int r, int c) { const int st = (r >> 4) * 2 + (c >> 5), rr = r & 15, cc = c & 31, ob = rr * 64 + cc * 2; return st * 1024 + (ob ^ (((ob >> 9) & 1) << 5)); }
__device__ __forceinline__ void stage_rc(int b, int& R, int& C) { const int st = b / 1024, sb = b % 1024, swz = sb ^ (((sb >> 9) & 1) << 5); R = (st >> 1) * 16 + swz / 64; C = (st & 1) * 32 + (swz % 64) / 2; }
__device__ __forceinline__ int perm32(int rho) { const int n = rho >> 4, i = rho & 15; return 8 * (i >> 2) + 4 * n + (i & 3); }

struct Unit { unsigned A, B, O, S1, G, G2; int ldc; int mode; };
constexpr unsigned NONE = 0xffffffffu;

template <class Epi, class Sched>
__device__ __forceinline__ void gemm_phase(LAS unsigned char* lds, const char* wsb, const int K, const int lda, const int ldb, const Sched& S, const Epi& E) {
    int tid = threadIdx.x; asm volatile("" : "+v"(tid));
    const int wid = __builtin_amdgcn_readfirstlane(tid >> 6), lane = tid & 63, wr = wid >> 2, wc = wid & 3, fr = lane & 15, fq = lane >> 4;
    const int nt = K / BK;
    unsigned voffA[2], voffB[2];
#pragma unroll
    for (int i = 0; i < 2; ++i) { int R, C; stage_rc(tid * 16 + i * 8192, R, C); const int Rb = (R & ~31) + perm32(R & 31);
        voffA[i] = (unsigned)(R * lda + C) * 2u; voffB[i] = (unsigned)(Rb * ldb + C) * 2u; }
    const size_t kstep = (size_t)(BK * 2);
    const size_t hstepA = (size_t)HALF * lda * 2, hstepB = (size_t)HALF * ldb * 2;
    const unsigned ldsw = (unsigned)wid * 1024u;
    int aoff = lds_byte(wr * 64 + fr, fq * 8), boff = lds_byte(wc * 32 + fr, fq * 8);
#define PG8_SA(b, h) (((b) * 2 + (h)) * HTB)
#define PG8_SB(b, h) ((4 + (b) * 2 + (h)) * HTB)
#define PG8_STAGE(bufoff, gbase, voff) do { _Pragma("unroll") for (int _i = 0; _i < 2; ++_i) \
        __builtin_amdgcn_global_load_lds((const unsigned*)((const char*)(gbase) + (voff)[_i]), (LAS unsigned*)(lds + (bufoff) + ldsw + _i * 8192), 16, 0, 0); } while (0)
#define PG8_LDA(dst, b, h) do { _Pragma("unroll") for (int m = 0; m < 4; ++m) _Pragma("unroll") for (int k = 0; k < 2; ++k) dst[m][k] = *(const LAS bf16x8*)(lds + PG8_SA(b, h) + aoff + m * 2048 + k * 1024); } while (0)
#define PG8_LDB(dst, b, h) do { _Pragma("unroll") for (int n = 0; n < 2; ++n) _Pragma("unroll") for (int k = 0; k < 2; ++k) dst[n][k] = *(const LAS bf16x8*)(lds + PG8_SB(b, h) + boff + n * 2048 + k * 1024); } while (0)
#define PG8_MMA(ai, bj, At, Bt) do { __builtin_amdgcn_s_setprio(1); _Pragma("unroll") for (int m = 0; m < 4; ++m) _Pragma("unroll") for (int n = 0; n < 2; ++n) _Pragma("unroll") for (int k = 0; k < 2; ++k) \
        acc[ai][bj][m][n] = __builtin_amdgcn_mfma_f32_16x16x32_bf16(Bt[n][k], At[m][k], acc[ai][bj][m][n], 0, 0, 0); __builtin_amdgcn_s_setprio(0); } while (0)
#define PG8_WAIT_V(n) asm volatile("s_waitcnt vmcnt(" #n ")" ::: "memory")
#define PG8_WAIT_L(n) asm volatile("s_waitcnt lgkmcnt(" #n ")" ::: "memory")
#define PG8_BAR __builtin_amdgcn_s_barrier()
#define PG8_SCHED __builtin_amdgcn_sched_barrier(0)
    Unit cur, nxt; int ui = 0;
    if (!S.next(0, cur)) return;
    f32x4 acc[2][2][4][2];
#pragma unroll
    for (int a = 0; a < 2; ++a)
#pragma unroll
        for (int b = 0; b < 2; ++b)
#pragma unroll
            for (int m = 0; m < 4; ++m)
#pragma unroll
                for (int n = 0; n < 2; ++n) acc[a][b][m][n] = (f32x4){0.f, 0.f, 0.f, 0.f};
    bf16x8 At[4][2], B0[2][2], B1[2][2];
    const char* cA = wsb + cur.A; const char* cB = wsb + cur.B;
    PG8_STAGE(PG8_SB(0, 0), cB, voffB); PG8_STAGE(PG8_SB(0, 1), cB + hstepB, voffB); PG8_STAGE(PG8_SA(0, 0), cA, voffA); PG8_STAGE(PG8_SA(0, 1), cA + hstepA, voffA);
    if (wr == 1) PG8_BAR;
    PG8_WAIT_V(2); PG8_BAR;
    PG8_STAGE(PG8_SB(1, 0), cB + kstep, voffB); PG8_STAGE(PG8_SA(1, 0), cA + kstep, voffA); PG8_STAGE(PG8_SB(1, 1), cB + hstepB + kstep, voffB);
    PG8_WAIT_V(6); PG8_BAR;
    for (;;) {
        if constexpr (Epi::CHAIN) {
            int l2_; asm volatile("v_mbcnt_lo_u32_b32 %0, -1, 0\n\tv_mbcnt_hi_u32_b32 %0, -1, %0" : "=v"(l2_));
            aoff = lds_byte(wr * 64 + (l2_ & 15), (l2_ >> 4) * 8); boff = lds_byte(wc * 32 + (l2_ & 15), (l2_ >> 4) * 8); }
        const bool has_next = S.next(ui + 1, nxt);
        const char* nA = has_next ? wsb + nxt.A : cA; const char* nB = has_next ? wsb + nxt.B : cB;
_Pragma("unroll 1")
        for (int t = 0; t < nt; t += 2) {
            const bool last = (t == nt - 2);
            const char* a1 = cA + (size_t)(t + 1) * kstep;
            const char* a2 = last ? nA : cA + (size_t)(t + 2) * kstep; const char* b2 = last ? nB : cB + (size_t)(t + 2) * kstep;
            const char* a3 = a2 + kstep; const char* b3 = b2 + kstep;
            PG8_LDB(B0, 0, 0); PG8_LDB(B1, 0, 1); PG8_SCHED; PG8_LDA(At, 0, 0); PG8_STAGE(PG8_SA(1, 1), a1 + hstepA, voffA);
            PG8_WAIT_V(8); PG8_WAIT_L(0); PG8_BAR; PG8_MMA(0, 0, At, B0); PG8_MMA(0, 1, At, B1); PG8_BAR; PG8_SCHED;
            PG8_LDA(At, 0, 1); PG8_STAGE(PG8_SB(0, 0), b2, voffB); PG8_STAGE(PG8_SB(0, 1), b2 + hstepB, voffB); PG8_STAGE(PG8_SA(0, 0), a2, voffA);
            PG8_WAIT_V(8); PG8_WAIT_L(0); PG8_BAR; PG8_MMA(1, 0, At, B0); PG8_MMA(1, 1, At, B1); PG8_BAR; PG8_SCHED;
            PG8_LDB(B0, 1, 0); PG8_LDB(B1, 1, 1); PG8_SCHED; PG8_LDA(At, 1, 0); PG8_STAGE(PG8_SA(0, 1), a2 + hstepA, voffA);
            PG8_WAIT_V(8); PG8_WAIT_L(0); PG8_BAR; PG8_MMA(0, 0, At, B0); PG8_MMA(0, 1, At, B1); PG8_BAR; PG8_SCHED;
            PG8_LDA(At, 1, 1); PG8_STAGE(PG8_SB(1, 0), b3, voffB); PG8_STAGE(PG8_SB(1, 1), b3 + hstepB, voffB); PG8_STAGE(PG8_SA(1, 0), a3, voffA);
            PG8_WAIT_V(8); PG8_WAIT_L(0); PG8_BAR; PG8_MMA(1, 0, At, B0); PG8_MMA(1, 1, At, B1); PG8_BAR; PG8_SCHED;
        }
        if (wr == 0) PG8_BAR;
        E(acc, cur, wr, wc, fr, fq);
        if (!has_next) break;
        if (!(Epi::CHAIN && cur.mode < 2))
#pragma unroll
        for (int a = 0; a < 2; ++a)
#pragma unroll
            for (int b = 0; b < 2; ++b)
#pragma unroll
                for (int m = 0; m < 4; ++m)
#pragma unroll
                    for (int n = 0; n < 2; ++n) acc[a][b][m][n] = (f32x4){0.f, 0.f, 0.f, 0.f};
        cur = nxt; cA = nA; cB = nB; ++ui;
        if (wr == 1) PG8_BAR;
    }
    PG8_WAIT_V(0);
    PG8_BAR;
#undef PG8_SA
#undef PG8_SB
#undef PG8_STAGE
#undef PG8_LDA
#undef PG8_LDB
#undef PG8_MMA
#undef PG8_WAIT_V
#undef PG8_WAIT_L
#undef PG8_BAR
#undef PG8_SCHED
}

__device__ __forceinline__ int xcd_remap(int L, int nwg) { const int q = nwg / 8, r = nwg % 8, xcd = L % 8, off = L / 8; return (xcd < r ? xcd * (q + 1) : r * (q + 1) + (xcd - r) * q) + off; }
__device__ __forceinline__ void tile_order(int w, int nM, int nN, int& pm, int& pn) { const int nig = 8 * nN, gid = w / nig, fm = gid * 8, gsz = (nM - fm) < 8 ? (nM - fm) : 8; pm = fm + ((w % nig) % gsz); pn = (w % nig) / gsz; }

typedef f32x4 Acc[2][2][4][2];
__device__ __forceinline__ u32x4 pack8(const f32x4 v0, const f32x4 v1) { u32x4 w; w.x = cvt_pk(v0[0], v0[1]); w.y = cvt_pk(v0[2], v0[3]); w.z = cvt_pk(v1[0], v1[1]); w.w = cvt_pk(v1[2], v1[3]); return w; }
}
using pg8::Unit; using pg8::Acc;

struct Args {
    const float *x, *mem, *norm1_g, *w_in, *conv_w, *conv_b, *fox_f_bias, *fox_q_g, *fox_k_g, *mem_norm_g, *w_mem_kv, *xa_q_g, *xa_k_g, *w_br_conv, *w_br_fox, *w_br_xa, *w_o, *norm2_g, *w_ffn_in, *w_ffn_out;
    float* out; unsigned char* ws;
};

struct Epi1 {
    static constexpr bool CHAIN = false;
    unsigned char* ws;
    __device__ __forceinline__ void operator()(const Acc& acc, const Unit& u, int wr, int wc, int fr, int fq) const {
        bf16_t* O = (bf16_t*)(ws + u.O); const int ldc = u.ldc; const int mode = u.mode;
        int ln_; asm volatile("v_mbcnt_lo_u32_b32 %0, -1, 0\n\tv_mbcnt_hi_u32_b32 %0, -1, %0" : "=v"(ln_)); (void)fr; (void)fq; const int r0 = wr * 64 + (ln_ & 15), c0 = wc * 32 + 8 * (ln_ >> 4);
        if (mode <= 1) {
#pragma unroll
            for (int ai = 0; ai < 2; ++ai)
#pragma unroll
                for (int m = 0; m < 4; ++m) { bf16_t* rowp = O + (size_t)(r0 + ai * 128 + m * 16) * ldc + c0;
#pragma unroll
                    for (int bj = 0; bj < 2; ++bj) { f32x4 v0 = acc[ai][bj][m][0], v1 = acc[ai][bj][m][1];
                        if (mode == 1) {
#pragma unroll
                            for (int j = 0; j < 4; ++j) { v0[j] = sigmoidf_(v0[j]); v1[j] = sigmoidf_(v1[j]); } }
                        *(GAS u32x4*)(rowp + bj * 128) = pg8::pack8(v0, v1); } }
        } else if (mode == 5) {
            unsigned char* O8 = (unsigned char*)(ws + u.O);
#pragma unroll
            for (int ai = 0; ai < 2; ++ai)
#pragma unroll
                for (int m = 0; m < 4; ++m) { unsigned char* rowp = O8 + (size_t)(r0 + ai * 128 + m * 16) * ldc + c0;
#pragma unroll
                    for (int bj = 0; bj < 2; ++bj) { const f32x4 v0 = acc[ai][bj][m][0], v1 = acc[ai][bj][m][1]; unsigned w0 = 0u, w1 = 0u;
#pragma unroll
                        for (int j = 0; j < 4; ++j) { w0 = __builtin_amdgcn_cvt_pk_u8_f32(sigmoidf_(v0[j]) * 255.f, j, w0); w1 = __builtin_amdgcn_cvt_pk_u8_f32(sigmoidf_(v1[j]) * 255.f, j, w1); }
                        *(GAS u32x2*)(rowp + bj * 128) = (u32x2){w0, w1}; } }
        } else if (mode == 2) {
#pragma unroll
            for (int ai = 0; ai < 2; ++ai)
#pragma unroll
                for (int m = 0; m < 4; ++m) { bf16_t* rowp = O + (size_t)(r0 + ai * 128 + m * 16) * ldc + c0;
                    *(GAS u32x4*)rowp = pg8::pack8(acc[ai][0][m][0] * acc[ai][1][m][0], acc[ai][0][m][1] * acc[ai][1][m][1]); }
        } else {
            GAS float* S1 = (GAS float*)(ws + u.S1); const float* Gp = (const float*)(ws + u.G);
            f32x4 g[2][2];
#pragma unroll
            for (int bj = 0; bj < 2; ++bj)
#pragma unroll
                for (int n = 0; n < 2; ++n) g[bj][n] = (u.G != pg8::NONE) ? *(const GAS f32x4*)(Gp + (mode == 4 ? bj * 128 : 0) + c0 + 4 * n) : (f32x4){1.f, 1.f, 1.f, 1.f};
#pragma unroll
            for (int ai = 0; ai < 2; ++ai)
#pragma unroll
                for (int m = 0; m < 4; ++m) { const int row = r0 + ai * 128 + m * 16; bf16_t* rowp = O + (size_t)row * ldc + c0;
                    float sq[2];
#pragma unroll
                    for (int bj = 0; bj < 2; ++bj) { const f32x4 v0 = acc[ai][bj][m][0], v1 = acc[ai][bj][m][1];
                        float q = (v0[0] * v0[0] + v0[1] * v0[1]) + (v0[2] * v0[2] + v0[3] * v0[3]) + (v1[0] * v1[0] + v1[1] * v1[1]) + (v1[2] * v1[2] + v1[3] * v1[3]);
                        q += __shfl_xor(q, 16); q += __shfl_xor(q, 32); sq[bj] = q;
                        *(GAS u32x4*)(rowp + bj * 128) = pg8::pack8(v0 * g[bj][0], v1 * g[bj][1]); }
                    if (fq == 0) {
                        if (mode == 3) { S1[row * 32 + wc] = sq[0]; S1[row * 32 + 4 + wc] = sq[1]; }
                        else S1[row * 16 + wc] = sq[0] + sq[1];
                    } }
        }
    }
};
struct EpiS {
    static constexpr bool CHAIN = false;
    unsigned char* ws;
    __device__ __forceinline__ void operator()(const Acc& acc, const Unit& u, int wr, int wc, int fr, int fq) const {
        bf16_t* O = (bf16_t*)(ws + u.O); GAS float* S1 = (GAS float*)(ws + u.S1); const float* Gq = (const float*)(ws + u.G); const float* Gk = (const float*)(ws + u.G2);
        int ln_; asm volatile("v_mbcnt_lo_u32_b32 %0, -1, 0\n\tv_mbcnt_hi_u32_b32 %0, -1, %0" : "=v"(ln_)); (void)fr; (void)fq; const int r0 = wr * 64 + (ln_ & 15), c0 = wc * 32 + 8 * (ln_ >> 4);
        f32x4 tk[2][8], tq[2][4];
#pragma unroll
        for (int bj = 0; bj < 2; ++bj)
#pragma unroll
            for (int j = 0; j < 8; ++j) tk[bj][j] = *(const GAS f32x4*)(Gk + (bj * 128 + c0 + j) * 16);
#pragma unroll
        for (int ai = 0; ai < 2; ++ai)
#pragma unroll
            for (int m = 0; m < 4; ++m) tq[ai][m] = *(const GAS f32x4*)(Gq + (r0 + ai * 128 + m * 16) * 16);
        float rk[2][8];
#pragma unroll
        for (int bj = 0; bj < 2; ++bj)
#pragma unroll
            for (int j = 0; j < 8; ++j) { const f32x4 p = tk[bj][j]; rk[bj][j] = __builtin_amdgcn_rsqf(((p[0] + p[1]) + (p[2] + p[3])) * (1.f / 256.f) + EPS); }
#pragma unroll
        for (int ai = 0; ai < 2; ++ai)
#pragma unroll
            for (int m = 0; m < 4; ++m) { const int row = r0 + ai * 128 + m * 16; bf16_t* rowp = O + row * 1024 + c0;
                const f32x4 p = tq[ai][m];
                const float rq = __builtin_amdgcn_rsqf(((p[0] + p[1]) + (p[2] + p[3])) * (1.f / 256.f) + EPS) * (LOG2E / 16.f);
                float sum = 0.f;
#pragma unroll
                for (int bj = 0; bj < 2; ++bj) { unsigned w[4];
#pragma unroll
                    for (int jj = 0; jj < 4; ++jj) { const int j0 = 2 * jj, j1 = 2 * jj + 1;
                        const float e0 = fexp2(acc[ai][bj][m][j0 >> 2][j0 & 3] * rq * rk[bj][j0]), e1 = fexp2(acc[ai][bj][m][j1 >> 2][j1 & 3] * rq * rk[bj][j1]);
                        w[jj] = cvt_pk(e0, e1); sum += bflo(w[jj]) + bfhi(w[jj]); }
                    *(GAS u32x4*)(rowp + bj * 128) = (u32x4){w[0], w[1], w[2], w[3]}; }
                sum += __shfl_xor(sum, 16); sum += __shfl_xor(sum, 32);
                if (fq == 0) S1[row * 16 + wc] = sum; }
    }
};
struct EpiPV {
    static constexpr bool CHAIN = false;
    unsigned char* ws;
    __device__ __forceinline__ void operator()(const Acc& acc, const Unit& u, int wr, int wc, int fr, int fq) const {
        bf16_t* O = (bf16_t*)(ws + u.O); const float* Gl = (const float*)(ws + u.G);
        int ln_; asm volatile("v_mbcnt_lo_u32_b32 %0, -1, 0\n\tv_mbcnt_hi_u32_b32 %0, -1, %0" : "=v"(ln_)); (void)fr; (void)fq; const int r0 = wr * 64 + (ln_ & 15), c0 = wc * 32 + 8 * (ln_ >> 4);
        f32x4 tl[2][4];
#pragma unroll
        for (int ai = 0; ai < 2; ++ai)
#pragma unroll
            for (int m = 0; m < 4; ++m) tl[ai][m] = *(const GAS f32x4*)(Gl + (r0 + ai * 128 + m * 16) * 16);
#pragma unroll
        for (int ai = 0; ai < 2; ++ai)
#pragma unroll
            for (int m = 0; m < 4; ++m) { const int row = r0 + ai * 128 + m * 16; bf16_t* rowp = O + row * 1024 + c0;
                const f32x4 p = tl[ai][m]; const float inv = 1.f / ((p[0] + p[1]) + (p[2] + p[3]));
#pragma unroll
                for (int bj = 0; bj < 2; ++bj) *(GAS u32x4*)(rowp + bj * 128) = pg8::pack8(acc[ai][bj][m][0] * inv, acc[ai][bj][m][1] * inv); }
    }
};
struct EpiGate {
    static constexpr bool CHAIN = true;
    unsigned char* ws;
    __device__ __forceinline__ void operator()(Acc& acc, const Unit& u, int wr, int wc, int fr, int fq) const {
        const unsigned char* Gt = (const unsigned char*)(ws + u.G); const int br = u.mode;
        int ln_; asm volatile("v_mbcnt_lo_u32_b32 %0, -1, 0\n\tv_mbcnt_hi_u32_b32 %0, -1, %0" : "=v"(ln_)); (void)fr; (void)fq;
        const int r0 = wr * 64 + (ln_ & 15), c0 = wc * 32 + 8 * (ln_ >> 4);
        if (br < 2) {
#pragma unroll
            for (int ai = 0; ai < 2; ++ai) {
                u32x2 ga[4][2], gb[4][2];
#pragma unroll
                for (int m = 0; m < 4; ++m)
#pragma unroll
                    for (int bj = 0; bj < 2; ++bj) { const unsigned char* gp = Gt + (r0 + ai * 128 + m * 16) * 3072 + c0 + bj * 128; ga[m][bj] = *(const GAS u32x2*)gp; gb[m][bj] = *(const GAS u32x2*)(gp + 1024); }
#pragma unroll
                for (int m = 0; m < 4; ++m)
#pragma unroll
                    for (int bj = 0; bj < 2; ++bj)
#pragma unroll
                        for (int j = 0; j < 4; ++j) {
                            const unsigned a0 = (ga[m][bj].x >> (8 * j)) & 0xffu, a1 = (ga[m][bj].y >> (8 * j)) & 0xffu, b0 = (gb[m][bj].x >> (8 * j)) & 0xffu, b1 = (gb[m][bj].y >> (8 * j)) & 0xffu;
                            acc[ai][bj][m][0][j] *= (float)(a0 ? a0 : 1u) * frcp((float)(b0 ? b0 : 1u));
                            acc[ai][bj][m][1][j] *= (float)(a1 ? a1 : 1u) * frcp((float)(b1 ? b1 : 1u)); }
            }
        } else {
            bf16_t* O = (bf16_t*)(ws + u.O);
#pragma unroll
            for (int ai = 0; ai < 2; ++ai) {
                u32x2 ga[4][2];
#pragma unroll
                for (int m = 0; m < 4; ++m)
#pragma unroll
                    for (int bj = 0; bj < 2; ++bj) ga[m][bj] = *(const GAS u32x2*)(Gt + (r0 + ai * 128 + m * 16) * 3072 + c0 + bj * 128);
#pragma unroll
                for (int m = 0; m < 4; ++m)
#pragma unroll
                    for (int bj = 0; bj < 2; ++bj) { f32x4 v0 = acc[ai][bj][m][0], v1 = acc[ai][bj][m][1];
#pragma unroll
                        for (int j = 0; j < 4; ++j) { const unsigned a0 = (ga[m][bj].x >> (8 * j)) & 0xffu, a1 = (ga[m][bj].y >> (8 * j)) & 0xffu;
                            v0[j] *= (float)(a0 ? a0 : 1u) * (1.f / 255.f); v1[j] *= (float)(a1 ? a1 : 1u) * (1.f / 255.f); }
                        *(GAS u32x4*)(O + (r0 + ai * 128 + m * 16) * 1024 + c0 + bj * 128) = pg8::pack8(v0, v1); }
            }
        }
    }
};
struct EpiRes1 {
    static constexpr bool CHAIN = false;
    unsigned char* ws; const float* x; float* out;
    __device__ __forceinline__ void operator()(const Acc& acc, const Unit& u, int wr, int wc, int fr, int fq) const {
        bf16_t* O = (bf16_t*)(ws + u.O); GAS float* S1 = (GAS float*)(ws + u.S1); const float* X = x + u.G;
        int ln_; asm volatile("v_mbcnt_lo_u32_b32 %0, -1, 0\n\tv_mbcnt_hi_u32_b32 %0, -1, %0" : "=v"(ln_)); (void)fr; (void)fq; const int r0 = wr * 64 + (ln_ & 15), c0 = wc * 32 + 8 * (ln_ >> 4);
#pragma unroll
        for (int ai = 0; ai < 2; ++ai) {
            f32x4 xv[4][2][2];
#pragma unroll
            for (int m = 0; m < 4; ++m)
#pragma unroll
                for (int bj = 0; bj < 2; ++bj) { const int off = (r0 + ai * 128 + m * 16) * 1024 + bj * 128 + c0; xv[m][bj][0] = *(const GAS f32x4*)(X + off); xv[m][bj][1] = *(const GAS f32x4*)(X + off + 4); }
#pragma unroll
            for (int m = 0; m < 4; ++m) { const int row = r0 + ai * 128 + m * 16; float q = 0.f;
#pragma unroll
                for (int bj = 0; bj < 2; ++bj) { const int off = row * 1024 + bj * 128 + c0;
                    const f32x4 v0 = acc[ai][bj][m][0] + xv[m][bj][0], v1 = acc[ai][bj][m][1] + xv[m][bj][1];
                    *(GAS u32x4*)(O + off) = pg8::pack8(v0, v1);
                    q += (v0[0] * v0[0] + v0[1] * v0[1]) + (v0[2] * v0[2] + v0[3] * v0[3]) + (v1[0] * v1[0] + v1[1] * v1[1]) + (v1[2] * v1[2] + v1[3] * v1[3]); }
                q += __shfl_xor(q, 16); q += __shfl_xor(q, 32);
                if (fq == 0) S1[row * 16 + wc] = q; }
        }
    }
};
struct EpiSwiglu {
    static constexpr bool CHAIN = false;
    unsigned char* ws;
    __device__ __forceinline__ void operator()(const Acc& acc, const Unit& u, int wr, int wc, int fr, int fq) const {
        bf16_t* O = (bf16_t*)(ws + u.O); const float* Gs = (const float*)(ws + u.G);
        int ln_; asm volatile("v_mbcnt_lo_u32_b32 %0, -1, 0\n\tv_mbcnt_hi_u32_b32 %0, -1, %0" : "=v"(ln_)); (void)fr; (void)fq; const int r0 = wr * 64 + (ln_ & 15), c0 = wc * 32 + 8 * (ln_ >> 4);
        f32x4 pp[2][4];
#pragma unroll
        for (int ai = 0; ai < 2; ++ai)
#pragma unroll
            for (int m = 0; m < 4; ++m) pp[ai][m] = *(const GAS f32x4*)(Gs + (r0 + ai * 128 + m * 16) * 16 + 4 * (ln_ >> 4));
#pragma unroll
        for (int ai = 0; ai < 2; ++ai)
#pragma unroll
            for (int m = 0; m < 4; ++m) { const int row = r0 + ai * 128 + m * 16;
                float sq = (pp[ai][m][0] + pp[ai][m][1]) + (pp[ai][m][2] + pp[ai][m][3]);
                sq += __shfl_xor(sq, 16); sq += __shfl_xor(sq, 32);
                const float rs = __builtin_amdgcn_rsqf(sq * (1.f / 1024.f) + EPS);
                f32x4 o[2];
#pragma unroll
                for (int n = 0; n < 2; ++n)
#pragma unroll
                    for (int j = 0; j < 4; ++j) { const float g = acc[ai][0][m][n][j] * rs, up = acc[ai][1][m][n][j] * rs; o[n][j] = g * sigmoidf_(g) * up; }
                *(GAS u32x4*)(O + row * DFF + c0) = pg8::pack8(o[0], o[1]); }
    }
};
struct EpiRes2 {
    static constexpr bool CHAIN = false;
    unsigned char* ws; float* out;
    __device__ __forceinline__ void operator()(const Acc& acc, const Unit& u, int wr, int wc, int fr, int fq) const {
        float* OUT = out + u.G; const bf16_t* XB = (const bf16_t*)(ws + u.O);
        int ln_; asm volatile("v_mbcnt_lo_u32_b32 %0, -1, 0\n\tv_mbcnt_hi_u32_b32 %0, -1, %0" : "=v"(ln_)); (void)fr; (void)fq; const int r0 = wr * 64 + (ln_ & 15), c0 = wc * 32 + 8 * (ln_ >> 4);
#pragma unroll
        for (int ai = 0; ai < 2; ++ai) {
            u32x4 xv[4][2];
#pragma unroll
            for (int m = 0; m < 4; ++m)
#pragma unroll
                for (int bj = 0; bj < 2; ++bj) xv[m][bj] = *(const GAS u32x4*)(XB + (r0 + ai * 128 + m * 16) * 1024 + bj * 128 + c0);
#pragma unroll
            for (int m = 0; m < 4; ++m)
#pragma unroll
                for (int bj = 0; bj < 2; ++bj) { const int off = (r0 + ai * 128 + m * 16) * 1024 + bj * 128 + c0; const u32x4 xb = xv[m][bj];
                    f32x4 v0 = acc[ai][bj][m][0], v1 = acc[ai][bj][m][1];
                    v0[0] += bflo(xb.x); v0[1] += bfhi(xb.x); v0[2] += bflo(xb.y); v0[3] += bfhi(xb.y); v1[0] += bflo(xb.z); v1[1] += bfhi(xb.z); v1[2] += bflo(xb.w); v1[3] += bfhi(xb.w);
                    *(GAS f32x4*)(OUT + off) = v0; *(GAS f32x4*)(OUT + off + 4) = v1; }
        }
    }
};

constexpr unsigned U(size_t v) { return (unsigned)v; }
struct Sched1 {
    int chunk, G, c, total;
    __device__ __forceinline__ bool next(int i, Unit& u) const {
        const int L = i * G + c; if (L >= total) return false;
        int w = pg8::xcd_remap(L, total); int pm, pn;
        const unsigned hoff = U(WS_H) + (unsigned)chunk * (TC * D * 2);
        u.S1 = pg8::NONE; u.G = pg8::NONE; u.G2 = pg8::NONE;
        if (w < 64 * NZT) {
            pg8::tile_order(w, 64, NZT, pm, pn);
            u.A = hoff + (unsigned)pm * (256 * D * 2); u.B = U(WS_WZ) + (unsigned)pn * (256 * D * 2);
            const unsigned rowoff = (unsigned)pm * 256;
            if (pn < 4) { u.mode = 0; u.ldc = 1024; u.O = U(WS_CB) + rowoff * 2048 + pn * 512; }
            else if (pn < 12) { u.mode = 2; u.ldc = 1024; u.O = U(WS_U) + rowoff * 2048 + (pn - 4) * 256; }
            else if (pn < 16) { u.mode = 3; u.ldc = 1024; u.O = U(WS_FQ) + rowoff * 2048 + (pn - 12) * 512; u.S1 = U(WS_SSQQ) + rowoff * 128 + (pn - 12) * 32; }
            else if (pn < 20) { u.mode = 3; u.ldc = 1024; u.O = U(WS_FK) + rowoff * 2048 + (pn - 16) * 512; u.S1 = U(WS_SSQK) + rowoff * 128 + (pn - 16) * 32; u.G = U(WS_SMALL); }
            else if (pn < 24) { u.mode = 4; u.ldc = 1024; u.O = U(WS_XQ) + rowoff * 2048 + (pn - 20) * 512; u.S1 = U(WS_SSQX) + rowoff * 64 + (pn - 20) * 16; }
            else { u.mode = 5; u.ldc = 3072; u.O = U(WS_GATES) + rowoff * 3072 + (pn - 24) * 256; }
            return true;
        }
        w -= 64 * NZT;
        if (w < 256) {
            pg8::tile_order(w, 4, 64, pm, pn);
            u.A = U(WS_WV) + (unsigned)pm * (256 * D * 2); u.B = hoff + (unsigned)pn * (256 * D * 2);
            u.mode = 0; u.ldc = TC; u.O = U(WS_VT) + (unsigned)pm * (256 * TC * 2) + pn * 512;
            return true;
        }
        w -= 256;
        if (w < 64) {
            pg8::tile_order(w, 16, 4, pm, pn);
            u.A = U(WS_MEMN) + (unsigned)pm * (256 * D * 2); u.B = U(WS_WKK) + (unsigned)pn * (256 * D * 2);
            u.mode = 4; u.ldc = 1024; u.O = U(WS_KMEM) + (unsigned)pm * (256 * 2048) + pn * 512; u.S1 = U(WS_SSQKM) + (unsigned)pm * (256 * 64) + pn * 16; u.G = U(WS_SMALL) + 512;
            return true;
        }
        w -= 64;
        pg8::tile_order(w, 4, 16, pm, pn);
        u.A = U(WS_WKV) + (unsigned)pm * (256 * D * 2); u.B = U(WS_MEMN) + (unsigned)pn * (256 * D * 2);
        u.mode = 0; u.ldc = 4096; u.O = U(WS_VTMEM) + (unsigned)pm * (256 * 4096 * 2) + pn * 512;
        return true;
    }
};
template <bool PV> struct SchedX {
    int chunk, G, c;
    __device__ __forceinline__ bool next(int i, Unit& u) const {
        const int L = i * G + c; if (L >= 256) return false;
        const unsigned hx = L & 3, qt = (L >> 2) & 7, bl = L >> 5; const unsigned bg = chunk * BC + bl; const unsigned row0 = bl * SEQ + qt * 256;
        u.mode = 0; u.ldc = 1024; u.G2 = pg8::NONE; u.S1 = pg8::NONE;
        if (!PV) {
            u.A = U(WS_XQ) + row0 * 2048 + hx * 512; u.B = U(WS_KMEM) + bg * (NMEM * 2048) + hx * 512;
            u.O = U(WS_P) + row0 * 2048 + hx * 512; u.S1 = U(WS_LSUM) + row0 * 64 + hx * 16;
            u.G = U(WS_SSQX) + row0 * 64 + hx * 16; u.G2 = U(WS_SSQKM) + bg * (NMEM * 64) + hx * 16;
        } else {
            u.A = U(WS_P) + row0 * 2048 + hx * 512; u.B = U(WS_VTMEM) + hx * (256 * 4096 * 2) + bg * (NMEM * 2);
            u.O = U(WS_XQ) + row0 * 2048 + hx * 512; u.G = U(WS_LSUM) + row0 * 64 + hx * 16;
        }
        return true;
    }
};
struct Sched3 {
    int chunk, G, c;
    __device__ __forceinline__ bool next(int i, Unit& u) const {
        const int tile = (i / 3) * G + c, br = i % 3; if (tile >= 256) return false;
        const unsigned xq_ = tile & 7, jq_ = tile >> 3; const unsigned pm = 8 * xq_ + (jq_ & 7), pn = jq_ >> 3; const unsigned row0 = pm * 256;
        const unsigned abuf = br == 0 ? U(WS_CB) : (br == 1 ? U(WS_FQ) : U(WS_XQ));
        u.A = abuf + row0 * 2048; u.B = U(WS_WBR) + (unsigned)br * (D * D * 2) + pn * (256 * D * 2);
        u.O = U(WS_H) + ((unsigned)chunk * TC + row0) * 2048 + pn * 512;
        u.G = U(WS_GATES) + row0 * 3072 + br * 1024 + pn * 256;
        u.mode = br; u.ldc = 1024; u.S1 = pg8::NONE; u.G2 = pg8::NONE;
        return true;
    }
};
template <int WHICH> struct SchedF {
    int G, c;
    __device__ __forceinline__ bool next(int i, Unit& u) const {
        constexpr int nM = T / 256, nN = (WHICH == 5) ? 22 : 4, total = nM * nN;
        const int L = i * G + c; if (L >= total) return false;
        int pm, pn; pg8::tile_order(pg8::xcd_remap(L, total), nM, nN, pm, pn);
        const unsigned row0 = (unsigned)pm * 256;
        u.mode = 0; u.ldc = 1024; u.S1 = pg8::NONE; u.G = pg8::NONE; u.G2 = pg8::NONE; u.O = pg8::NONE;
        if (WHICH == 4) {
            u.A = U(WS_H) + row0 * 2048; u.B = U(WS_WO) + (unsigned)pn * (256 * D * 2);
            u.O = U(WS_X1B) + row0 * 2048 + pn * 512; u.S1 = U(WS_SSQ2) + row0 * 64 + pn * 16;
            u.G = row0 * 1024 + pn * 256;
        } else if (WHICH == 5) {
            u.A = U(WS_X1B) + row0 * 2048; u.B = U(WS_WFI) + (unsigned)pn * (256 * D * 2);
            u.O = U(WS_ACT) + row0 * (DFF * 2) + pn * 256; u.G = U(WS_SSQ2) + row0 * 64;
        } else {
            u.A = U(WS_ACT) + row0 * (DFF * 2); u.B = U(WS_WFO) + (unsigned)pn * (256 * DFF * 2);
            u.O = U(WS_X1B) + row0 * 2048 + pn * 512;
            u.G = row0 * 1024 + pn * 256;
        }
        return true;
    }
};

__device__ __forceinline__ void tr_item(const float* W, int ldw, int srccol, int k0, bf16_t* WT, int K, int drow, const float* kscale, LAS float* scr, int lane) {
    float tv[32];
#pragma unroll
    for (int i = 0; i < 32; ++i) { const int kk = 2 * i + (lane >> 5); tv[i] = __builtin_nontemporal_load((const GAS float*)W + ((size_t)(k0 + kk) * ldw + srccol + (lane & 31))); }
    if (kscale) {
#pragma unroll
        for (int i = 0; i < 32; ++i) tv[i] *= ((const GAS float*)kscale)[k0 + 2 * i + (lane >> 5)]; }
#pragma unroll
    for (int i = 0; i < 32; ++i) scr[(2 * i + (lane >> 5)) * 33 + (lane & 31)] = tv[i];
    LDS_WAIT();
    const int c = lane & 7;
#pragma unroll
    for (int j = 0; j < 4; ++j) { const int n = (lane >> 3) + 8 * j; const LAS float* s = scr + (8 * c) * 33 + n;
        u32x4 o; o.x = cvt_pk(s[0 * 33], s[1 * 33]); o.y = cvt_pk(s[2 * 33], s[3 * 33]); o.z = cvt_pk(s[4 * 33], s[5 * 33]); o.w = cvt_pk(s[6 * 33], s[7 * 33]);
        *(GAS u32x4*)(WT + (size_t)(drow + n) * K + k0 + 8 * c) = o; }
    LDS_WAIT();
}
__device__ __forceinline__ int zsrc(int np) { const int tj = np >> 8, o = np & 255;
    if (tj < 4) return np;
    if (tj < 12) { const int j = tj - 4; return (o < 128) ? 1024 + 128 * j + o : 2048 + 128 * j + (o - 128); }
    if (tj < 16) return 3072 + (np - 12 * 256);
    if (tj < 20) return 4096 + (np - 16 * 256);
    if (tj < 24) return 6144 + (np - 20 * 256);
    return 7168 + (np - 24 * 256); }
__device__ __forceinline__ int fsrc(int np) { const int tj = np >> 8, o = np & 255; return (o < 128) ? 128 * tj + o : DFF + 128 * tj + (o - 128); }

__device__ __forceinline__ void p0_prologue(const Args& a, LAS unsigned char* lds, int G) {
    unsigned char* ws = a.ws;
    int tid = threadIdx.x; asm volatile("" : "+v"(tid));
    const int lane = tid & 63, wave = tid >> 6;
    LAS float* scr = (LAS float*)(lds + wave * 8704);
    LAS float* wff = (LAS float*)(lds + 81920);
    float wfv[16];
#pragma unroll
    for (int q_ = 0; q_ < 16; ++q_) { const int idx = tid + 512 * q_; const int o = idx & 3, l = (idx >> 2) & 63, je = (idx >> 8) & 15, half = idx >> 12;
        const int k = 256 * (je >> 2) + 4 * l + (je & 3); wfv[q_] = ((const GAS float*)a.norm1_g)[k] * ((const GAS float*)a.w_in)[(size_t)k * INCOLS + 10240 + 4 * half + o]; }
    if (blockIdx.x == 0) { float* sm = (float*)(ws + WS_SMALL);
        if (tid < 128) sm[tid] = a.fox_q_g[tid] * a.fox_k_g[tid];
        if (tid < 256) sm[128 + tid] = a.xa_q_g[tid] * a.xa_k_g[tid]; }
    const int gw = blockIdx.x * 8 + wave, NGW = G * 8;
    constexpr int I0 = 16 * 288, I1 = 512, I9 = 44 * 32, I8 = 16 * 176;
    constexpr int NITEMS = I0 + 7 * I1 + I8 + I9;
    for (int it = gw; it < NITEMS; it += NGW) {
        int r = it;
        if (r < I0) { const int kb = r / 288, nb = r % 288; tr_item(a.w_in, INCOLS, zsrc(32 * nb), 64 * kb, (bf16_t*)(ws + WS_WZ), D, 32 * nb, nullptr, scr, lane); continue; } r -= I0;
        if (r < I1) { const int kb = r / 32, nb = r % 32; tr_item(a.w_in, INCOLS, 5120 + 32 * nb, 64 * kb, (bf16_t*)(ws + WS_WV), D, 32 * nb, nullptr, scr, lane); continue; } r -= I1;
        if (r < I1) { const int kb = r / 32, nb = r % 32; tr_item(a.w_mem_kv, 2048, 32 * nb, 64 * kb, (bf16_t*)(ws + WS_WKK), D, 32 * nb, nullptr, scr, lane); continue; } r -= I1;
        if (r < I1) { const int kb = r / 32, nb = r % 32; tr_item(a.w_mem_kv, 2048, 1024 + 32 * nb, 64 * kb, (bf16_t*)(ws + WS_WKV), D, 32 * nb, nullptr, scr, lane); continue; } r -= I1;
        if (r < I1) { const int kb = r / 32, nb = r % 32; tr_item(a.w_br_conv, D, 32 * nb, 64 * kb, (bf16_t*)(ws + WS_WBR), D, 32 * nb, nullptr, scr, lane); continue; } r -= I1;
        if (r < I1) { const int kb = r / 32, nb = r % 32; tr_item(a.w_br_fox, D, 32 * nb, 64 * kb, (bf16_t*)(ws + WS_WBR) + (size_t)D * D, D, 32 * nb, nullptr, scr, lane); continue; } r -= I1;
        if (r < I1) { const int kb = r / 32, nb = r % 32; tr_item(a.w_br_xa, D, 32 * nb, 64 * kb, (bf16_t*)(ws + WS_WBR) + (size_t)2 * D * D, D, 32 * nb, nullptr, scr, lane); continue; } r -= I1;
        if (r < I1) { const int kb = r / 32, nb = r % 32; tr_item(a.w_o, D, 32 * nb, 64 * kb, (bf16_t*)(ws + WS_WO), D, 32 * nb, nullptr, scr, lane); continue; } r -= I1;
        if (r < I8) { const int kb = r / 176, nb = r % 176; tr_item(a.w_ffn_in, 2 * DFF, fsrc(32 * nb), 64 * kb, (bf16_t*)(ws + WS_WFI), D, 32 * nb, a.norm2_g, scr, lane); continue; } r -= I8;
        { const int kb = r / 32, nb = r % 32; tr_item(a.w_ffn_out, D, 32 * nb, 64 * kb, (bf16_t*)(ws + WS_WFO), DFF, 32 * nb, nullptr, scr, lane); }
    }
#pragma unroll
    for (int q_ = 0; q_ < 16; ++q_) wff[tid + 512 * q_] = wfv[q_];
    __syncthreads();
    f32x4 g1[4], gm[4];
#pragma unroll
    for (int j = 0; j < 4; ++j) { g1[j] = *(const GAS f32x4*)(a.norm1_g + 256 * j + 4 * lane); gm[j] = *(const GAS f32x4*)(a.mem_norm_g + 256 * j + 4 * lane); }
    for (int m0 = gw; m0 < T + NBATCH * NMEM; m0 += 2 * NGW) {
        f32x4 v2[2][4]; const int m1 = m0 + NGW; const bool has1 = m1 < T + NBATCH * NMEM;
#pragma unroll
        for (int rr = 0; rr < 2; ++rr) { const int m = rr ? (has1 ? m1 : m0) : m0; const float* xr = (m < T) ? a.x + (size_t)m * D : a.mem + (size_t)(m - T) * D;
#pragma unroll
            for (int j = 0; j < 4; ++j) v2[rr][j] = __builtin_nontemporal_load((const GAS f32x4*)(xr + 256 * j + 4 * lane)); }
#pragma unroll
        for (int rr = 0; rr < 2; ++rr) {
            if (rr == 1 && !has1) break;
            const int m = rr ? m1 : m0;
            const bool isx = m < T;
            bf16_t* orow = isx ? (bf16_t*)(ws + WS_H) + (size_t)m * D : (bf16_t*)(ws + WS_MEMN) + (size_t)(m - T) * D;
            f32x4 v[4]; float s = 0.f;
#pragma unroll
            for (int j = 0; j < 4; ++j) { v[j] = v2[rr][j]; s += (v[j][0] * v[j][0] + v[j][1] * v[j][1]) + (v[j][2] * v[j][2] + v[j][3] * v[j][3]); }
            const float rstd = 1.f / sqrtf(wave_sum(s) * (1.f / D) + EPS);
#pragma unroll
            for (int j = 0; j < 4; ++j) { const f32x4 gg = isx ? g1[j] : gm[j]; const f32x4 o = v[j] * rstd * gg;
                *(GAS u32x2*)(orow + 256 * j + 4 * lane) = (u32x2){cvt_pk(o[0], o[1]), cvt_pk(o[2], o[3])}; }
            if (isx) {
                f32x4 fa = {0.f, 0.f, 0.f, 0.f}, fb = {0.f, 0.f, 0.f, 0.f};
#pragma unroll
                for (int j = 0; j < 4; ++j)
#pragma unroll
                    for (int e = 0; e < 4; ++e) { const int je = j * 4 + e; const f32x4 wa = *(const LAS f32x4*)(wff + (je * 64 + lane) * 4), wb = *(const LAS f32x4*)(wff + ((16 + je) * 64 + lane) * 4);
                        fa += wa * v[j][e]; fb += wb * v[j][e]; }
                float tot[8];
#pragma unroll
                for (int o = 0; o < 4; ++o) { tot[o] = wave_sum(fa[o]); tot[4 + o] = wave_sum(fb[o]); }
                float mine = tot[0];
#pragma unroll
                for (int o = 1; o < 8; ++o) mine = (lane == o) ? tot[o] : mine;
                if (lane < 8) { const float z = mine * rstd + ((const GAS float*)a.fox_f_bias)[lane];
                    const float ls = fminf(z, 0.f) - log1pf(expf(-fabsf(z)));
                    ((GAS float*)(ws + WS_LOGF))[(size_t)m * 8 + lane] = ls; }
            }
        }
    }
}

__device__ __forceinline__ void cumsum_bh(unsigned char* ws, int b, int h, int lane) {
    asm volatile("" : "+v"(lane));
    const GAS float* lf = (const GAS float*)(ws + WS_LOGF) + ((size_t)b * SEQ + 32 * lane) * 8 + h;
    float v[32]; float run = 0.f;
#pragma unroll
    for (int i = 0; i < 32; ++i) { run += lf[i * 8]; v[i] = run; }
    float incl = run;
#pragma unroll
    for (int o = 1; o < 64; o <<= 1) { const float t = __shfl_up(incl, o); if (lane >= o) incl += t; }
    const float base = incl - run;
    GAS float* c2 = (GAS float*)(ws + WS_C2) + ((size_t)(b * NH + h)) * SEQ + 32 * lane;
#pragma unroll
    for (int i = 0; i < 8; ++i) *(GAS f32x4*)(c2 + 4 * i) = (f32x4){(v[4 * i] + base) * LOG2E, (v[4 * i + 1] + base) * LOG2E, (v[4 * i + 2] + base) * LOG2E, (v[4 * i + 3] + base) * LOG2E};
}

__device__ __forceinline__ void conv_item(unsigned char* ws, const float* conv_w, const float* conv_b, int item, int tid) {
    asm volatile("" : "+v"(tid));
    const int cgp = tid & 127, tr = tid >> 7; const int ch = 8 * cgp; const int t0 = item * 32 + tr * 8;
    bf16_t* cb = (bf16_t*)(ws + WS_CB); const bf16_t* ub = (const bf16_t*)(ws + WS_U);
    float w0[8], w1[8], w2[8], bb[8];
#pragma unroll
    for (int j = 0; j < 8; ++j) { w0[j] = ((const GAS float*)conv_w)[ch + j]; w1[j] = ((const GAS float*)conv_w)[D + ch + j]; w2[j] = ((const GAS float*)conv_w)[2 * D + ch + j]; bb[j] = ((const GAS float*)conv_b)[ch + j]; }
    float um2[8], um1[8];
    const bool first = (t0 % SEQ) == 0;
    { u32x4 p2 = {0u, 0u, 0u, 0u}, p1 = {0u, 0u, 0u, 0u};
      if (!first) { p2 = *(const GAS u32x4*)(ub + (size_t)(t0 - 2) * D + ch); p1 = *(const GAS u32x4*)(ub + (size_t)(t0 - 1) * D + ch); }
      um2[0] = bflo(p2.x); um2[1] = bfhi(p2.x); um2[2] = bflo(p2.y); um2[3] = bfhi(p2.y); um2[4] = bflo(p2.z); um2[5] = bfhi(p2.z); um2[6] = bflo(p2.w); um2[7] = bfhi(p2.w);
      um1[0] = bflo(p1.x); um1[1] = bfhi(p1.x); um1[2] = bflo(p1.y); um1[3] = bfhi(p1.y); um1[4] = bflo(p1.z); um1[5] = bfhi(p1.z); um1[6] = bflo(p1.w); um1[7] = bfhi(p1.w); }
    u32x4 pu[8], pc[8];
#pragma unroll
    for (int i = 0; i < 8; ++i) { pu[i] = *(const GAS u32x4*)(ub + (size_t)(t0 + i) * D + ch); pc[i] = *(const GAS u32x4*)(cb + (size_t)(t0 + i) * D + ch); }
#pragma unroll
    for (int i = 0; i < 8; ++i) {
        float uu[8], cc[8], y[8];
        uu[0] = bflo(pu[i].x); uu[1] = bfhi(pu[i].x); uu[2] = bflo(pu[i].y); uu[3] = bfhi(pu[i].y); uu[4] = bflo(pu[i].z); uu[5] = bfhi(pu[i].z); uu[6] = bflo(pu[i].w); uu[7] = bfhi(pu[i].w);
        cc[0] = bflo(pc[i].x); cc[1] = bfhi(pc[i].x); cc[2] = bflo(pc[i].y); cc[3] = bfhi(pc[i].y); cc[4] = bflo(pc[i].z); cc[5] = bfhi(pc[i].z); cc[6] = bflo(pc[i].w); cc[7] = bfhi(pc[i].w);
#pragma unroll
        for (int j = 0; j < 8; ++j) { y[j] = cc[j] * (w0[j] * um2[j] + w1[j] * um1[j] + w2[j] * uu[j] + bb[j]); um2[j] = um1[j]; um1[j] = uu[j]; }
        *(GAS u32x4*)(cb + (size_t)(t0 + i) * D + ch) = (u32x4){cvt_pk(y[0], y[1]), cvt_pk(y[2], y[3]), cvt_pk(y[4], y[5]), cvt_pk(y[6], y[7])};
    }
}

constexpr int FX_KP = 272, FX_VP = 144, FX_KOFF = 0, FX_VOFF = 64 * FX_KP, FX_COFF = FX_VOFF + 128 * FX_VP, FX_STG = FX_COFF + 256;
__device__ __forceinline__ void fox_unit(LAS unsigned char* lds, unsigned char* ws, int bl, int bg, int h, int qblk) {
    int tid = threadIdx.x; asm volatile("" : "+v"(tid));
    const int lane = tid & 63, wave = __builtin_amdgcn_readfirstlane(tid >> 6), ql = lane & 31, hi = lane >> 5;
    const GAS bf16_t* FQ = (const GAS bf16_t*)(ws + WS_FQ); const GAS bf16_t* FK = (const GAS bf16_t*)(ws + WS_FK); const GAS bf16_t* VT = (const GAS bf16_t*)(ws + WS_VT);
    const GAS float* ssqq = (const GAS float*)(ws + WS_SSQQ); const GAS float* ssqk = (const GAS float*)(ws + WS_SSQK);
    const GAS float* c2 = (const GAS float*)(ws + WS_C2) + (size_t)(bg * NH + h) * SEQ;
    const int q0 = qblk * 256 + 32 * wave, qa = q0 + ql;
    const size_t qrow = (size_t)bl * SEQ + qa;
    bf16x8 qf[8];
    { const f32x4 p = *(const GAS f32x4*)(ssqq + qrow * 32 + 4 * h);
      const float sc = __builtin_amdgcn_rsqf(((p[0] + p[1]) + (p[2] + p[3])) * (1.f / 128.f) + EPS) * (LOG2E * 0.08838834764831845f);
#pragma unroll
      for (int ds = 0; ds < 8; ++ds) { const u32x4 r = *(const GAS u32x4*)(FQ + qrow * 1024 + h * 128 + 16 * ds + 8 * hi);
          u32x4 o; o.x = cvt_pk(bflo(r.x) * sc, bfhi(r.x) * sc); o.y = cvt_pk(bflo(r.y) * sc, bfhi(r.y) * sc); o.z = cvt_pk(bflo(r.z) * sc, bfhi(r.z) * sc); o.w = cvt_pk(bflo(r.w) * sc, bfhi(r.w) * sc);
          qf[ds] = __builtin_bit_cast(bf16x8, o); } }
    f32x16 ot[4];
#pragma unroll
    for (int i = 0; i < 4; ++i)
#pragma unroll
        for (int r = 0; r < 16; ++r) ot[i][r] = 0.f;
    float mrun = -1e30f, lrun = 0.f;
    const int nkt = qblk * 4 + 4, kt_diag = q0 >> 6;
    const int krow = tid >> 3, kpc = tid & 7, vrow = tid >> 2, vpc = tid & 3;
    u32x4 kr0, kr1, vr0, vr1; f32x4 kss; float ckv = 0.f;
#define FX_GLOAD(kt_) do { const int s0_ = (kt_) * 64; const size_t kr_ = (size_t)bl * SEQ + s0_ + krow; \
        const GAS bf16_t* kp_ = FK + kr_ * 1024 + h * 128 + 16 * kpc; kr0 = *(const GAS u32x4*)kp_; kr1 = *(const GAS u32x4*)(kp_ + 8); kss = *(const GAS f32x4*)(ssqk + kr_ * 32 + 4 * h); \
        const GAS bf16_t* vp_ = VT + (size_t)(h * 128 + vrow) * TC + (size_t)bl * SEQ + s0_ + 16 * vpc; vr0 = *(const GAS u32x4*)vp_; vr1 = *(const GAS u32x4*)(vp_ + 8); \
        if (tid < 64) ckv = c2[s0_ + tid]; } while (0)
#define FX_SCALE2(w_, rk_) cvt_pk(bflo(w_) * (rk_), bfhi(w_) * (rk_))
#define FX_LSTORE(stg_) do { LAS unsigned char* sb_ = lds + (stg_) * FX_STG; \
        const float rk_ = __builtin_amdgcn_rsqf(((kss[0] + kss[1]) + (kss[2] + kss[3])) * (1.f / 128.f) + EPS); \
        u32x4 a_, b_; a_.x = FX_SCALE2(kr0.x, rk_); a_.y = FX_SCALE2(kr0.y, rk_); a_.z = FX_SCALE2(kr0.z, rk_); a_.w = FX_SCALE2(kr0.w, rk_); \
        b_.x = FX_SCALE2(kr1.x, rk_); b_.y = FX_SCALE2(kr1.y, rk_); b_.z = FX_SCALE2(kr1.z, rk_); b_.w = FX_SCALE2(kr1.w, rk_); \
        *(LAS u32x4*)(sb_ + FX_KOFF + krow * FX_KP + kpc * 32) = a_; *(LAS u32x4*)(sb_ + FX_KOFF + krow * FX_KP + kpc * 32 + 16) = b_; \
        LAS unsigned char* vd_ = sb_ + FX_VOFF + vrow * FX_VP + vpc * 32; \
        *(LAS u32x4*)(vd_) = (u32x4){vr0.x, vr0.y, vr1.x, vr1.y}; *(LAS u32x4*)(vd_ + 16) = (u32x4){vr0.z, vr0.w, vr1.z, vr1.w};   \
        if (tid < 64) *(LAS float*)(sb_ + FX_COFF + tid * 4) = ckv; } while (0)
    FX_GLOAD(nkt - 1); FX_LSTORE(0); FX_GLOAD(nkt - 2);
    __syncthreads();
    for (int it = 0; it < nkt; ++it) {
        const int kt = nkt - 1 - it;
        if (it + 1 < nkt) FX_LSTORE((it + 1) & 1);
        if (it + 2 < nkt) FX_GLOAD(kt - 2);
        if (kt <= kt_diag) {
            LAS unsigned char* sb = lds + (it & 1) * FX_STG;
            const LAS float* cks = (const LAS float*)(sb + FX_COFF);
            f32x16 s0, s1;
#pragma unroll
            for (int g = 0; g < 4; ++g) { const f32x4 c0 = *(const LAS f32x4*)(cks + 8 * g + 4 * hi), c1 = *(const LAS f32x4*)(cks + 32 + 8 * g + 4 * hi);
#pragma unroll
                for (int e = 0; e < 4; ++e) { s0[4 * g + e] = -c0[e]; s1[4 * g + e] = -c1[e]; } }
            const LAS unsigned char* kb0 = sb + FX_KOFF + ql * FX_KP + hi * 16;
#pragma unroll
            for (int ds = 0; ds < 8; ++ds) { const bf16x8 a0 = *(const LAS bf16x8*)(kb0 + ds * 32), a1 = *(const LAS bf16x8*)(kb0 + 32 * FX_KP + ds * 32);
                s0 = __builtin_amdgcn_mfma_f32_32x32x16_bf16(a0, qf[ds], s0, 0, 0, 0); s1 = __builtin_amdgcn_mfma_f32_32x32x16_bf16(a1, qf[ds], s1, 0, 0, 0); }
            const int krel = qa - kt * 64;
            if (kt == kt_diag) {
#pragma unroll
                for (int r = 0; r < 16; ++r) { const int key = 8 * (r >> 2) + 4 * hi + (r & 3); if (key > krel) s0[r] = -INFINITY; if (key + 32 > krel) s1[r] = -INFINITY; }
                asm volatile("" ::: "memory");
            }
            float mloc = -INFINITY;
#pragma unroll
            for (int r = 0; r < 16; ++r) mloc = fmaxf(mloc, fmaxf(s0[r], s1[r]));
            mloc = fmaxf(mloc, __shfl_xor(mloc, 32));
            const float mnew = fmaxf(mrun, mloc), alpha = fexp2(mrun - mnew);
            float psum = 0.f;
#pragma unroll
            for (int r = 0; r < 16; ++r) { s0[r] = fexp2(s0[r] - mnew); s1[r] = fexp2(s1[r] - mnew); psum += s0[r] + s1[r]; }
            psum += __shfl_xor(psum, 32);
            lrun = lrun * alpha + psum; mrun = mnew;
            if (__builtin_amdgcn_ballot_w64(alpha != 1.0f)) {
#pragma unroll
                for (int i = 0; i < 4; ++i)
#pragma unroll
                    for (int r = 0; r < 16; ++r) ot[i][r] *= alpha;
            }
            bf16x8 pf[4];
#pragma unroll
            for (int j = 0; j < 2; ++j) {
                u32x4 a = {cvt_pk(s0[8 * j], s0[8 * j + 1]), cvt_pk(s0[8 * j + 2], s0[8 * j + 3]), cvt_pk(s0[8 * j + 4], s0[8 * j + 5]), cvt_pk(s0[8 * j + 6], s0[8 * j + 7])};
                u32x4 b = {cvt_pk(s1[8 * j], s1[8 * j + 1]), cvt_pk(s1[8 * j + 2], s1[8 * j + 3]), cvt_pk(s1[8 * j + 4], s1[8 * j + 5]), cvt_pk(s1[8 * j + 6], s1[8 * j + 7])};
                pf[j] = __builtin_bit_cast(bf16x8, a); pf[2 + j] = __builtin_bit_cast(bf16x8, b); }
            const LAS unsigned char* vb0 = sb + FX_VOFF + ql * FX_VP + hi * 16;
#pragma unroll
            for (int db = 0; db < 4; ++db)
#pragma unroll
                for (int st = 0; st < 4; ++st) { const bf16x8 vf = *(const LAS bf16x8*)(vb0 + db * 32 * FX_VP + st * 32);
                    ot[db] = __builtin_amdgcn_mfma_f32_32x32x16_bf16(vf, pf[st], ot[db], 0, 0, 0); }
        }
        __syncthreads();
    }
#undef FX_GLOAD
#undef FX_SCALE2
#undef FX_LSTORE
    const float inv = 1.f / lrun;
    GAS bf16_t* op = (GAS bf16_t*)(ws + WS_FQ) + qrow * 1024 + h * 128 + 4 * hi;
#pragma unroll
    for (int db = 0; db < 4; ++db)
#pragma unroll
        for (int g = 0; g < 4; ++g) *(GAS u32x2*)(op + 32 * db + 8 * g) = (u32x2){cvt_pk(ot[db][4 * g] * inv, ot[db][4 * g + 1] * inv), cvt_pk(ot[db][4 * g + 2] * inv, ot[db][4 * g + 3] * inv)};
}

__device__ __forceinline__ void grid_bar(unsigned char* ws, int k, int G, int tid) {
    unsigned* base = (unsigned*)(ws + WS_BAR) + k * 512;
    asm volatile("s_waitcnt vmcnt(0) lgkmcnt(0)" ::: "memory");
    __syncthreads();
    if (tid == 0) {
        const unsigned c = blockIdx.x, g = c & 7u, ng = (unsigned)G < 8u ? (unsigned)G : 8u, members = ((unsigned)G - g + 7u) >> 3;
        __builtin_amdgcn_fence(__ATOMIC_RELEASE, "agent");
        asm volatile("s_waitcnt vmcnt(0)" ::: "memory");
        const unsigned old = __hip_atomic_fetch_add(base + 32 * g, 1u, __ATOMIC_ACQ_REL, __HIP_MEMORY_SCOPE_AGENT);
        if (old + 1u == members) __hip_atomic_fetch_add(base + 256, 1u, __ATOMIC_ACQ_REL, __HIP_MEMORY_SCOPE_AGENT);
        unsigned spins = 0;
        while (__hip_atomic_load(base + 256, __ATOMIC_RELAXED, __HIP_MEMORY_SCOPE_AGENT) < ng) { __builtin_amdgcn_s_sleep(1); if (++spins > (1u << 22)) break; }
        __builtin_amdgcn_fence(__ATOMIC_ACQUIRE, "agent");
        asm volatile("s_waitcnt vmcnt(0)" ::: "memory");
    }
    __syncthreads();
}

template <unsigned PHM, bool COOP>
__global__ void __launch_bounds__(512, 2) hybrid_fwd(Args a, int ch_lo, int ch_hi) {
    __shared__ __attribute__((aligned(16))) unsigned char lds_raw[LDS_BYTES];
    LAS unsigned char* lds = (LAS unsigned char*)lds_raw;
#define PHON(k) ((PHM >> (k)) & 1u)
#define SEAM(k) do { if constexpr (COOP) { grid_bar(ws, (k), G, tid); } } while (0)
#define FRESH() unsigned char* ws = a.ws; int G = gridDim.x, c = blockIdx.x, tid = threadIdx.x; asm volatile("" : "+s"(ws)); asm volatile("" : "+s"(G)); asm volatile("" : "+s"(c)); asm volatile("" : "+v"(tid))
    if constexpr (PHON(0)) { FRESH(); (void)c; (void)tid; (void)ws; p0_prologue(a, lds, G); if constexpr (COOP) { if (G == 0x7fffffff) cg::this_grid().sync(); } SEAM(15); }

#pragma unroll 1
    for (int ch = ch_lo; ch < ch_hi; ++ch) {
        if constexpr (PHON(1)) { FRESH(); if (ch == 0) {
            const int nb_ = G >= 16 ? 16 : G, c0_ = c - (G - nb_);
            if (c0_ >= 0) for (int bh = c0_ * 8 + __builtin_amdgcn_readfirstlane(tid >> 6); bh < NBATCH * NH; bh += nb_ * 8) cumsum_bh(ws, bh >> 3, bh & 7, tid & 63); } }
        if constexpr (PHON(2)) { FRESH(); (void)tid; Sched1 S{ch, G, c, 64 * NZT + 256 + (ch == 0 ? 128 : 0)}; Epi1 E{ws};
          pg8::gemm_phase<Epi1, Sched1>(lds, (const char*)ws, D, D, D, S, E); SEAM(1 + 3 * ch); }
        if constexpr (PHON(3)) { FRESH(); (void)tid; SchedX<false> S{ch, G, c}; EpiS E{ws}; pg8::gemm_phase<EpiS, SchedX<false>>(lds, (const char*)ws, 256, 1024, 1024, S, E);
          __builtin_amdgcn_fence(__ATOMIC_ACQUIRE, "agent"); asm volatile("s_waitcnt vmcnt(0)" ::: "memory"); __syncthreads(); }
        if constexpr (PHON(6)) { FRESH(); (void)tid; SchedX<true> S{ch, G, c}; EpiPV E{ws}; pg8::gemm_phase<EpiPV, SchedX<true>>(lds, (const char*)ws, 256, 1024, 4096, S, E); }
        if constexpr (PHON(4)) { FRESH(); for (int it = c; it < TC / 32; it += G) conv_item(ws, a.conv_w, a.conv_b, it, tid); }
        if constexpr (PHON(5)) { FRESH(); (void)tid; for (int p = c; p < 256; p += G) { const int bh = 8 * (p & 7) + (p >> 5), j = (p >> 3) & 3; const int bl = bh >> 3, h = bh & 7;
            fox_unit(lds, ws, bl, ch * BC + bl, h, 7 - j); __syncthreads(); fox_unit(lds, ws, bl, ch * BC + bl, h, j); __syncthreads(); }
          SEAM(2 + 3 * ch); }
        if constexpr (PHON(7)) { FRESH(); (void)tid; Sched3 S{ch, G, c}; EpiGate E{ws}; pg8::gemm_phase<EpiGate, Sched3>(lds, (const char*)ws, D, D, D, S, E); SEAM(3 + 3 * ch); }
    }
    if constexpr (PHON(8)) { FRESH(); (void)tid; SchedF<4> S{G, c}; EpiRes1 E{ws, a.x, a.out}; pg8::gemm_phase<EpiRes1, SchedF<4>>(lds, (const char*)ws, D, D, D, S, E); SEAM(8); }
    if constexpr (PHON(9)) { FRESH(); (void)tid; SchedF<5> S{G, c}; EpiSwiglu E{ws}; pg8::gemm_phase<EpiSwiglu, SchedF<5>>(lds, (const char*)ws, D, D, D, S, E); SEAM(9); }
    if constexpr (PHON(10)) { FRESH(); (void)tid; SchedF<6> S{G, c}; EpiRes2 E{ws, a.out}; pg8::gemm_phase<EpiRes2, SchedF<6>>(lds, (const char*)ws, DFF, DFF, DFF, S, E); }
}

#ifndef N_LAUNCH_MODE
#define N_LAUNCH_MODE 1
#endif
template <unsigned PHM> static void launch_plain(const Args& a, int lo, int hi, int grid, hipStream_t stream) {
    hipLaunchKernelGGL((hybrid_fwd<PHM, false>), dim3(grid), dim3(512), 0, stream, a, lo, hi);
}

extern "C" void kernel_launch(void* const* d_in, const int* in_sizes, int n_in, void* d_out, int out_size, void* d_ws, size_t ws_size, hipStream_t stream) {
    static int grid = 0;
    if (grid == 0) {
        if (n_in != 20 || out_size != T * D || ws_size < WS_END) { fprintf(stderr, "kernel_launch: unexpected shapes (n_in %d out %d ws %zu)\n", n_in, out_size, ws_size); grid = -1; return; }
        int dev = 0, cus = 0;
        (void)hipGetDevice(&dev); (void)hipDeviceGetAttribute(&cus, hipDeviceAttributeMultiprocessorCount, dev);
        (void)hipGetLastError();
        grid = cus > 0 ? cus : 256;
    }
    if (grid < 0) return;
    Args a{};
    const float** p = (const float**)&a;
    for (int i = 0; i < 20; ++i) p[i] = (const float*)d_in[i];
    a.out = (float*)d_out; a.ws = (unsigned char*)d_ws;
#if N_LAUNCH_MODE == 1
    (void)hipMemsetAsync((unsigned char*)d_ws + WS_BAR, 0, 16 * 2048, stream);
    int lo = 0, hi = NCH;
    void* args[] = {&a, &lo, &hi};
    hipError_t e = hipLaunchCooperativeKernel((const void*)hybrid_fwd<0x7ffu, true>, dim3(grid), dim3(512), args, 0, stream);
    if (e != hipSuccess) fprintf(stderr, "cooperative launch failed: %s (grid %d)\n", hipGetErrorString(e), grid);
#else
    launch_plain<0x1u>(a, 0, 0, grid, stream);
    for (int ch = 0; ch < NCH; ++ch) {
        if (ch == 0) launch_plain<0x2u>(a, ch, ch + 1, grid, stream);
        launch_plain<0x4u>(a, ch, ch + 1, grid, stream);
        launch_plain<0x78u>(a, ch, ch + 1, grid, stream);
        launch_plain<0x80u>(a, ch, ch + 1, grid, stream);
    }
    launch_plain<0x100u>(a, 0, 0, grid, stream);
    launch_plain<0x200u>(a, 0, 0, grid, stream);
    launch_plain<0x400u>(a, 0, 0, grid, stream);
#endif
}
```

```cpp
#include <hip/hip_runtime.h>
#include <hip/hip_cooperative_groups.h>
#include <cstdint>
#include <cstdio>
namespace cg = cooperative_groups;

#define LAS __attribute__((address_space(3)))
#define GAS __attribute__((address_space(1)))
typedef unsigned short bf16_t;
typedef short bf16x8 __attribute__((ext_vector_type(8)));
typedef float f32x4 __attribute__((ext_vector_type(4)));
typedef float f32x16 __attribute__((ext_vector_type(16)));
typedef unsigned u32x4 __attribute__((ext_vector_type(4)));
typedef unsigned u32x2 __attribute__((ext_vector_type(2)));

constexpr int T = 32768, D = 1024, SEQ = 2048, NBATCH = 16, NCH = 2, BC = 8, TC = BC * SEQ;
constexpr int NH = 8, HD = 128, NMEM = 256, DFF = 2816, INCOLS = 10248;
constexpr float EPS = 1e-6f, LOG2E = 1.4426950408889634f;
constexpr int NZT = 36;
constexpr size_t MiB = 1u << 20;
constexpr size_t WS_WZ = 0, WS_WV = 18 * MiB, WS_WKK = 20 * MiB, WS_WKV = 22 * MiB, WS_WBR = 24 * MiB, WS_WO = 30 * MiB, WS_WFI = 32 * MiB, WS_WFO = 43 * MiB;
constexpr size_t WS_SMALL = 49 * MiB, WS_LOGF = 50 * MiB, WS_C2 = 51 * MiB, WS_H = 52 * MiB, WS_MEMN = 116 * MiB, WS_KMEM = 124 * MiB, WS_VTMEM = 132 * MiB;
constexpr size_t WS_SSQQ = 140 * MiB, WS_SSQK = 142 * MiB, WS_SSQX = 144 * MiB, WS_SSQKM = 145 * MiB, WS_LSUM = 146 * MiB, WS_SSQ2 = 147 * MiB;
constexpr size_t WS_CB = 152 * MiB, WS_U = 184 * MiB, WS_FQ = 216 * MiB, WS_FK = 248 * MiB, WS_VT = 280 * MiB, WS_XQ = 312 * MiB, WS_GATES = 344 * MiB, WS_P = 440 * MiB;
constexpr size_t WS_X1B = 152 * MiB, WS_ACT = 216 * MiB, WS_END = 472 * MiB;
constexpr int LDS_BYTES = 131072;
constexpr size_t WS_BAR = WS_SMALL + 65536;

typedef float f32x2_t __attribute__((ext_vector_type(2)));
typedef __bf16 bf16x2_t __attribute__((ext_vector_type(2)));
__device__ __forceinline__ unsigned cvt_pk(float lo, float hi) { f32x2_t v = {lo, hi}; bf16x2_t b = __builtin_convertvector(v, bf16x2_t); return __builtin_bit_cast(unsigned, b); }
__device__ __forceinline__ float bflo(unsigned u) { return __builtin_bit_cast(float, u << 16); }
__device__ __forceinline__ float bfhi(unsigned u) { return __builtin_bit_cast(float, u & 0xffff0000u); }
__device__ __forceinline__ float wave_sum(float v) {
#pragma unroll
    for (int o = 1; o < 64; o <<= 1) v += __shfl_xor(v, o);
    return v;
}
__device__ __forceinline__ float fexp2(float x) { return __builtin_amdgcn_exp2f(x); }
__device__ __forceinline__ float frcp(float x) { return __builtin_amdgcn_rcpf(x); }
__device__ __forceinline__ float sigmoidf_(float v) { return frcp(1.f + fexp2(-v * LOG2E)); }
#define LDS_WAIT() asm volatile("s_waitcnt lgkmcnt(0)" ::: "memory")

namespace pg8 {
constexpr int BM = 256, BK = 64, HALF = 128, HTB = HALF * BK * 2, STAGE_BYTES = 8 * HTB;
__device__ __forceinline__ int lds_byte(int r, int c) { const int st = (r >> 4) * 2 + (c >> 5), rr = r & 15, cc = c & 31, ob = rr * 64 + cc * 2; return st * 1024 + (ob ^ (((ob >> 9) & 1) << 5)); }
__device__ __forceinline__ void stage_rc(int b, int& R, int& C) { const int st = b / 1024, sb = b % 1024, swz = sb ^ (((sb >> 9) & 1) << 5); R = (st >> 1) * 16 + swz / 64; C = (st & 1) * 32 + (swz % 64) / 2; }
__device__ __forceinline__ int perm32(int rho) { const int n = rho >> 4, i = rho & 15; return 8 * (i >> 2) + 4 * n + (i & 3); }

struct Unit { unsigned A, B, O, S1, G, G2; int ldc; int mode; };
constexpr unsigned NONE = 0xffffffffu;

template <class Epi, class Sched>
__device__ __forceinline__ void gemm_phase(LAS unsigned char* lds, const char* wsb, const int K, const int lda, const int ldb, const Sched& S, const Epi& E) {
    int tid = threadIdx.x; asm volatile("" : "+v"(tid));
    const int wid = __builtin_amdgcn_readfirstlane(tid >> 6), lane = tid & 63, wr = wid >> 2, wc = wid & 3, fr = lane & 15, fq = lane >> 4;
    const int nt = K / BK;
    unsigned voffA[2], voffB[2];
#pragma unroll
    for (int i = 0; i < 2; ++i) { int R, C; stage_rc(tid * 16 + i * 8192, R, C); const int Rb = (R & ~31) + perm32(R & 31);
        voffA[i] = (unsigned)(R * lda + C) * 2u; voffB[i] = (unsigned)(Rb * ldb + C) * 2u; }
    const size_t kstep = (size_t)(BK * 2);
    const size_t hstepA = (size_t)HALF * lda * 2, hstepB = (size_t)HALF * ldb * 2;
    const unsigned ldsw = (unsigned)wid * 1024u;
    int aoff = lds_byte(wr * 64 + fr, fq * 8), boff = lds_byte(wc * 32 + fr, fq * 8);
#define PG8_SA(b, h) (((b) * 2 + (h)) * HTB)
#define PG8_SB(b, h) ((4 + (b) * 2 + (h)) * HTB)
#define PG8_STAGE(bufoff, gbase, voff) do { _Pragma("unroll") for (int _i = 0; _i < 2; ++_i) \
        __builtin_amdgcn_global_load_lds((const unsigned*)((const char*)(gbase) + (voff)[_i]), (LAS unsigned*)(lds + (bufoff) + ldsw + _i * 8192), 16, 0, 0); } while (0)
#define PG8_LDA(dst, b, h) do { _Pragma("unroll") for (int m = 0; m < 4; ++m) _Pragma("unroll") for (int k = 0; k < 2; ++k) dst[m][k] = *(const LAS bf16x8*)(lds + PG8_SA(b, h) + aoff + m * 2048 + k * 1024); } while (0)
#define PG8_LDB(dst, b, h) do { _Pragma("unroll") for (int n = 0; n < 2; ++n) _Pragma("unroll") for (int k = 0; k < 2; ++k) dst[n][k] = *(const LAS bf16x8*)(lds + PG8_SB(b, h) + boff + n * 2048 + k * 1024); } while (0)
#define PG8_MMA(ai, bj, At, Bt) do { __builtin_amdgcn_s_setprio(1); _Pragma("unroll") for (int m = 0; m < 4; ++m) _Pragma("unroll") for (int n = 0; n < 2; ++n) _Pragma("unroll") for (int k = 0; k < 2; ++k) \
        acc[ai][bj][m][n] = __builtin_amdgcn_mfma_f32_16x16x32_bf16(Bt[n][k], At[m][k], acc[ai][bj][m][n], 0, 0, 0); __builtin_amdgcn_s_setprio(0); } while (0)
#define PG8_WAIT_V(n) asm volatile("s_waitcnt vmcnt(" #n ")" ::: "memory")
#define PG8_WAIT_L(n) asm volatile("s_waitcnt lgkmcnt(" #n ")" ::: "memory")
#define PG8_BAR __builtin_amdgcn_s_barrier()
#define PG8_SCHED __builtin_amdgcn_sched_barrier(0)
    Unit cur, nxt; int ui = 0;
    if (!S.next(0, cur)) return;
    f32x4 acc[2][2][4][2];
#pragma unroll
    for (int a = 0; a < 2; ++a)
#pragma unroll
        for (int b = 0; b < 2; ++b)
#pragma unroll
            for (int m = 0; m < 4; ++m)
#pragma unroll
                for (int n = 0; n < 2; ++n) acc[a][b][m][n] = (f32x4){0.f, 0.f, 0.f, 0.f};
    bf16x8 At[4][2], B0[2][2], B1[2][2];
    const char* cA = wsb + cur.A; const char* cB = wsb + cur.B;
    PG8_STAGE(PG8_SB(0, 0), cB, voffB); PG8_STAGE(PG8_SB(0, 1), cB + hstepB, voffB); PG8_STAGE(PG8_SA(0, 0), cA, voffA); PG8_STAGE(PG8_SA(0, 1), cA + hstepA, voffA);
    if (wr == 1) PG8_BAR;
    PG8_WAIT_V(2); PG8_BAR;
    PG8_STAGE(PG8_SB(1, 0), cB + kstep, voffB); PG8_STAGE(PG8_SA(1, 0), cA + kstep, voffA); PG8_STAGE(PG8_SB(1, 1), cB + hstepB + kstep, voffB);
    PG8_WAIT_V(6); PG8_BAR;
    for (;;) {
        if constexpr (Epi::CHAIN) {
            int l2_; asm volatile("v_mbcnt_lo_u32_b32 %0, -1, 0\n\tv_mbcnt_hi_u32_b32 %0, -1, %0" : "=v"(l2_));
            aoff = lds_byte(wr * 64 + (l2_ & 15), (l2_ >> 4) * 8); boff = lds_byte(wc * 32 + (l2_ & 15), (l2_ >> 4) * 8); }
        const bool has_next = S.next(ui + 1, nxt);
        const char* nA = has_next ? wsb + nxt.A : cA; const char* nB = has_next ? wsb + nxt.B : cB;
_Pragma("unroll 1")
        for (int t = 0; t < nt; t += 2) {
            const bool last = (t == nt - 2);
            const char* a1 = cA + (size_t)(t + 1) * kstep;
            const char* a2 = last ? nA : cA + (size_t)(t + 2) * kstep; const char* b2 = last ? nB : cB + (size_t)(t + 2) * kstep;
            const char* a3 = a2 + kstep; const char* b3 = b2 + kstep;
            PG8_LDB(B0, 0, 0); PG8_LDB(B1, 0, 1); PG8_SCHED; PG8_LDA(At, 0, 0); PG8_STAGE(PG8_SA(1, 1), a1 + hstepA, voffA);
            PG8_WAIT_V(8); PG8_WAIT_L(0); PG8_BAR; PG8_MMA(0, 0, At, B0); PG8_MMA(0, 1, At, B1); PG8_BAR; PG8_SCHED;
            PG8_LDA(At, 0, 1); PG8_STAGE(PG8_SB(0, 0), b2, voffB); PG8_STAGE(PG8_SB(0, 1), b2 + hstepB, voffB); PG8_STAGE(PG8_SA(0, 0), a2, voffA);
            PG8_WAIT_V(8); PG8_WAIT_L(0); PG8_BAR; PG8_MMA(1, 0, At, B0); PG8_MMA(1, 1, At, B1); PG8_BAR; PG8_SCHED;
            PG8_LDB(B0, 1, 0); PG8_LDB(B1, 1, 1); PG8_SCHED; PG8_LDA(At, 1, 0); PG8_STAGE(PG8_SA(0, 1), a2 + hstepA, voffA);
            PG8_WAIT_V(8); PG8_WAIT_L(0); PG8_BAR; PG8_MMA(0, 0, At, B0); PG8_MMA(0, 1, At, B1); PG8_BAR; PG8_SCHED;
            PG8_LDA(At, 1, 1); PG8_STAGE(PG8_SB(1, 0), b3, voffB); PG8_STAGE(PG8_SB(1, 1), b3 + hstepB, voffB); PG8_STAGE(PG8_SA(1, 0), a3, voffA);
            PG8_WAIT_V(8); PG8_WAIT_L(0); PG8_BAR; PG8_MMA(1, 0, At, B0); PG8_MMA(1, 1, At, B1); PG8_BAR; PG8_SCHED;
        }
        if (wr == 0) PG8_BAR;
        E(acc, cur, wr, wc, fr, fq);
        if (!has_next) break;
        if (!(Epi::CHAIN && cur.mode < 2))
#pragma unroll
        for (int a = 0; a < 2; ++a)
#pragma unroll
            for (int b = 0; b < 2; ++b)
#pragma unroll
                for (int m = 0; m < 4; ++m)
#pragma unroll
                    for (int n = 0; n < 2; ++n) acc[a][b][m][n] = (f32x4){0.f, 0.f, 0.f, 0.f};
        cur = nxt; cA = nA; cB = nB; ++ui;
        if (wr == 1) PG8_BAR;
    }
    PG8_WAIT_V(0);
    PG8_BAR;
#undef PG8_SA
#undef PG8_SB
#undef PG8_STAGE
#undef PG8_LDA
#undef PG8_LDB
#undef PG8_MMA
#undef PG8_WAIT_V
#undef PG8_WAIT_L
#undef PG8_BAR
#undef PG8_SCHED
}

__device__ __forceinline__ int xcd_remap(int L, int nwg) { const int q = nwg / 8, r = nwg % 8, xcd = L % 8, off = L / 8; return (xcd < r ? xcd * (q + 1) : r * (q + 1) + (xcd - r) * q) + off; }
__device__ __forceinline__ void tile_order(int w, int nM, int nN, int& pm, int& pn) { const int nig = 8 * nN, gid = w / nig, fm = gid * 8, gsz = (nM - fm) < 8 ? (nM - fm) : 8; pm = fm + ((w % nig) % gsz); pn = (w % nig) / gsz; }

typedef f32x4 Acc[2][2][4][2];
__device__ __forceinline__ u32x4 pack8(const f32x4 v0, const f32x4 v1) { u32x4 w; w.x = cvt_pk(v0[0], v0[1]); w.y = cvt_pk(v0[2], v0[3]); w.z = cvt_pk(v1[0], v1[1]); w.w = cvt_pk(v1[2], v1[3]); return w; }
}
using pg8::Unit; using pg8::Acc;

struct Args {
    const float *x, *mem, *norm1_g, *w_in, *conv_w, *conv_b, *fox_f_bias, *fox_q_g, *fox_k_g, *mem_norm_g, *w_mem_kv, *xa_q_g, *xa_k_g, *w_br_conv, *w_br_fox, *w_br_xa, *w_o, *norm2_g, *w_ffn_in, *w_ffn_out;
    float* out; unsigned char* ws;
};

struct Epi1 {
    static constexpr bool CHAIN = false;
    unsigned char* ws;
    __device__ __forceinline__ void operator()(const Acc& acc, const Unit& u, int wr, int wc, int fr, int fq) const {
        bf16_t* O = (bf16_t*)(ws + u.O); const int ldc = u.ldc; const int mode = u.mode;
        int ln_; asm volatile("v_mbcnt_lo_u32_b32 %0, -1, 0\n\tv_mbcnt_hi_u32_b32 %0, -1, %0" : "=v"(ln_)); (void)fr; (void)fq; const int r0 = wr * 64 + (ln_ & 15), c0 = wc * 32 + 8 * (ln_ >> 4);
        if (mode <= 1) {
#pragma unroll
            for (int ai = 0; ai < 2; ++ai)
#pragma unroll
                for (int m = 0; m < 4; ++m) { bf16_t* rowp = O + (size_t)(r0 + ai * 128 + m * 16) * ldc + c0;
#pragma unroll
                    for (int bj = 0; bj < 2; ++bj) { f32x4 v0 = acc[ai][bj][m][0], v1 = acc[ai][bj][m][1];
                        if (mode == 1) {
#pragma unroll
                            for (int j = 0; j < 4; ++j) { v0[j] = sigmoidf_(v0[j]); v1[j] = sigmoidf_(v1[j]); } }
                        *(GAS u32x4*)(rowp + bj * 128) = pg8::pack8(v0, v1); } }
        } else if (mode == 5) {
            unsigned char* O8 = (unsigned char*)(ws + u.O);
#pragma unroll
            for (int ai = 0; ai < 2; ++ai)
#pragma unroll
                for (int m = 0; m < 4; ++m) { unsigned char* rowp = O8 + (size_t)(r0 + ai * 128 + m * 16) * ldc + c0;
#pragma unroll
                    for (int bj = 0; bj < 2; ++bj) { const f32x4 v0 = acc[ai][bj][m][0], v1 = acc[ai][bj][m][1]; unsigned w0 = 0u, w1 = 0u;
#pragma unroll
                        for (int j = 0; j < 4; ++j) { w0 = __builtin_amdgcn_cvt_pk_u8_f32(sigmoidf_(v0[j]) * 255.f, j, w0); w1 = __builtin_amdgcn_cvt_pk_u8_f32(sigmoidf_(v1[j]) * 255.f, j, w1); }
                        *(GAS u32x2*)(rowp + bj * 128) = (u32x2){w0, w1}; } }
        } else if (mode == 2) {
#pragma unroll
            for (int ai = 0; ai < 2; ++ai)
#pragma unroll
                for (int m = 0; m < 4; ++m) { bf16_t* rowp = O + (size_t)(r0 + ai * 128 + m * 16) * ldc + c0;
                    *(GAS u32x4*)rowp = pg8::pack8(acc[ai][0][m][0] * acc[ai][1][m][0], acc[ai][0][m][1] * acc[ai][1][m][1]); }
        } else {
            GAS float* S1 = (GAS float*)(ws + u.S1); const float* Gp = (const float*)(ws + u.G);
            f32x4 g[2][2];
#pragma unroll
            for (int bj = 0; bj < 2; ++bj)
#pragma unroll
                for (int n = 0; n < 2; ++n) g[bj][n] = (u.G != pg8::NONE) ? *(const GAS f32x4*)(Gp + (mode == 4 ? bj * 128 : 0) + c0 + 4 * n) : (f32x4){1.f, 1.f, 1.f, 1.f};
#pragma unroll
            for (int ai = 0; ai < 2; ++ai)
#pragma unroll
                for (int m = 0; m < 4; ++m) { const int row = r0 + ai * 128 + m * 16; bf16_t* rowp = O + (size_t)row * ldc + c0;
                    float sq[2];
#pragma unroll
                    for (int bj = 0; bj < 2; ++bj) { const f32x4 v0 = acc[ai][bj][m][0], v1 = acc[ai][bj][m][1];
                        float q = (v0[0] * v0[0] + v0[1] * v0[1]) + (v0[2] * v0[2] + v0[3] * v0[3]) + (v1[0] * v1[0] + v1[1] * v1[1]) + (v1[2] * v1[2] + v1[3] * v1[3]);
                        q += __shfl_xor(q, 16); q += __shfl_xor(q, 32); sq[bj] = q;
                        *(GAS u32x4*)(rowp + bj * 128) = pg8::pack8(v0 * g[bj][0], v1 * g[bj][1]); }
                    if (fq == 0) {
                        if (mode == 3) { S1[row * 32 + wc] = sq[0]; S1[row * 32 + 4 + wc] = sq[1]; }
                        else S1[row * 16 + wc] = sq[0] + sq[1];
                    } }
        }
    }
};
struct EpiS {
    static constexpr bool CHAIN = false;
    unsigned char* ws;
    __device__ __forceinline__ void operator()(const Acc& acc, const Unit& u, int wr, int wc, int fr, int fq) const {
        bf16_t* O = (bf16_t*)(ws + u.O); GAS float* S1 = (GAS float*)(ws + u.S1); const float* Gq = (const float*)(ws + u.G); const float* Gk = (const float*)(ws + u.G2);
        int ln_; asm volatile("v_mbcnt_lo_u32_b32 %0, -1, 0\n\tv_mbcnt_hi_u32_b32 %0, -1, %0" : "=v"(ln_)); (void)fr; (void)fq; const int r0 = wr * 64 + (ln_ & 15), c0 = wc * 32 + 8 * (ln_ >> 4);
        f32x4 tk[2][8], tq[2][4];
#pragma unroll
        for (int bj = 0; bj < 2; ++bj)
#pragma unroll
            for (int j = 0; j < 8; ++j) tk[bj][j] = *(const GAS f32x4*)(Gk + (bj * 128 + c0 + j) * 16);
#pragma unroll
        for (int ai = 0; ai < 2; ++ai)
#pragma unroll
            for (int m = 0; m < 4; ++m) tq[ai][m] = *(const GAS f32x4*)(Gq + (r0 + ai * 128 + m * 16) * 16);
        float rk[2][8];
#pragma unroll
        for (int bj = 0; bj < 2; ++bj)
#pragma unroll
            for (int j = 0; j < 8; ++j) { const f32x4 p = tk[bj][j]; rk[bj][j] = __builtin_amdgcn_rsqf(((p[0] + p[1]) + (p[2] + p[3])) * (1.f / 256.f) + EPS); }
#pragma unroll
        for (int ai = 0; ai < 2; ++ai)
#pragma unroll
            for (int m = 0; m < 4; ++m) { const int row = r0 + ai * 128 + m * 16; bf16_t* rowp = O + row * 1024 + c0;
                const f32x4 p = tq[ai][m];
                const float rq = __builtin_amdgcn_rsqf(((p[0] + p[1]) + (p[2] + p[3])) * (1.f / 256.f) + EPS) * (LOG2E / 16.f);
                float sum = 0.f;
#pragma unroll
                for (int bj = 0; bj < 2; ++bj) { unsigned w[4];
#pragma unroll
                    for (int jj = 0; jj < 4; ++jj) { const int j0 = 2 * jj, j1 = 2 * jj + 1;
                        const float e0 = fexp2(acc[ai][bj][m][j0 >> 2][j0 & 3] * rq * rk[bj][j0]), e1 = fexp2(acc[ai][bj][m][j1 >> 2][j1 & 3] * rq * rk[bj][j1]);
                        w[jj] = cvt_pk(e0, e1); sum += bflo(w[jj]) + bfhi(w[jj]); }
                    *(GAS u32x4*)(rowp + bj * 128) = (u32x4){w[0], w[1], w[2], w[3]}; }
                sum += __shfl_xor(sum, 16); sum += __shfl_xor(sum, 32);
                if (fq == 0) S1[row * 16 + wc] = sum; }
    }
};
struct EpiPV {
    static constexpr bool CHAIN = false;
    unsigned char* ws;
    __device__ __forceinline__ void operator()(const Acc& acc, const Unit& u, int wr, int wc, int fr, int fq) const {
        bf16_t* O = (bf16_t*)(ws + u.O); const float* Gl = (const float*)(ws + u.G);
        int ln_; asm volatile("v_mbcnt_lo_u32_b32 %0, -1, 0\n\tv_mbcnt_hi_u32_b32 %0, -1, %0" : "=v"(ln_)); (void)fr; (void)fq; const int r0 = wr * 64 + (ln_ & 15), c0 = wc * 32 + 8 * (ln_ >> 4);
        f32x4 tl[2][4];
#pragma unroll
        for (int ai = 0; ai < 2; ++ai)
#pragma unroll
            for (int m = 0; m < 4; ++m) tl[ai][m] = *(const GAS f32x4*)(Gl + (r0 + ai * 128 + m * 16) * 16);
#pragma unroll
        for (int ai = 0; ai < 2; ++ai)
#pragma unroll
            for (int m = 0; m < 4; ++m) { const int row = r0 + ai * 128 + m * 16; bf16_t* rowp = O + row * 1024 + c0;
                const f32x4 p = tl[ai][m]; const float inv = 1.f / ((p[0] + p[1]) + (p[2] + p[3]));
#pragma unroll
                for (int bj = 0; bj < 2; ++bj) *(GAS u32x4*)(rowp + bj * 128) = pg8::pack8(acc[ai][bj][m][0] * inv, acc[ai][bj][m][1] * inv); }
    }
};
struct EpiGate {
    static constexpr bool CHAIN = true;
    unsigned char* ws;
    __device__ __forceinline__ void operator()(Acc& acc, const Unit& u, int wr, int wc, int fr, int fq) const {
        const unsigned char* Gt = (const unsigned char*)(ws + u.G); const int br = u.mode;
        int ln_; asm volatile("v_mbcnt_lo_u32_b32 %0, -1, 0\n\tv_mbcnt_hi_u32_b32 %0, -1, %0" : "=v"(ln_)); (void)fr; (void)fq;
        const int r0 = wr * 64 + (ln_ & 15), c0 = wc * 32 + 8 * (ln_ >> 4);
        if (br < 2) {
#pragma unroll
            for (int ai = 0; ai < 2; ++ai) {
                u32x2 ga[4][2], gb[4][2];
#pragma unroll
                for (int m = 0; m < 4; ++m)
#pragma unroll
                    for (int bj = 0; bj < 2; ++bj) { const unsigned char* gp = Gt + (r0 + ai * 128 + m * 16) * 3072 + c0 + bj * 128; ga[m][bj] = *(const GAS u32x2*)gp; gb[m][bj] = *(const GAS u32x2*)(gp + 1024); }
#pragma unroll
                for (int m = 0; m < 4; ++m)
#pragma unroll
                    for (int bj = 0; bj < 2; ++bj)
#pragma unroll
                        for (int j = 0; j < 4; ++j) {
                            const unsigned a0 = (ga[m][bj].x >> (8 * j)) & 0xffu, a1 = (ga[m][bj].y >> (8 * j)) & 0xffu, b0 = (gb[m][bj].x >> (8 * j)) & 0xffu, b1 = (gb[m][bj].y >> (8 * j)) & 0xffu;
                            acc[ai][bj][m][0][j] *= (float)(a0 ? a0 : 1u) * frcp((float)(b0 ? b0 : 1u));
                            acc[ai][bj][m][1][j] *= (float)(a1 ? a1 : 1u) * frcp((float)(b1 ? b1 : 1u)); }
            }
        } else {
            bf16_t* O = (bf16_t*)(ws + u.O);
#pragma unroll
            for (int ai = 0; ai < 2; ++ai) {
                u32x2 ga[4][2];
#pragma unroll
                for (int m = 0; m < 4; ++m)
#pragma unroll
                    for (int bj = 0; bj < 2; ++bj) ga[m][bj] = *(const GAS u32x2*)(Gt + (r0 + ai * 128 + m * 16) * 3072 + c0 + bj * 128);
#pragma unroll
                for (int m = 0; m < 4; ++m)
#pragma unroll
                    for (int bj = 0; bj < 2; ++bj) { f32x4 v0 = acc[ai][bj][m][0], v1 = acc[ai][bj][m][1];
#pragma unroll
                        for (int j = 0; j < 4; ++j) { const unsigned a0 = (ga[m][bj].x >> (8 * j)) & 0xffu, a1 = (ga[m][bj].y >> (8 * j)) & 0xffu;
                            v0[j] *= (float)(a0 ? a0 : 1u) * (1.f / 255.f); v1[j] *= (float)(a1 ? a1 : 1u) * (1.f / 255.f); }
                        *(GAS u32x4*)(O + (r0 + ai * 128 + m * 16) * 1024 + c0 + bj * 128) = pg8::pack8(v0, v1); }
            }
        }
    }
};
struct EpiRes1 {
    static constexpr bool CHAIN = false;
    unsigned char* ws; const float* x; float* out;
    __device__ __forceinline__ void operator()(const Acc& acc, const Unit& u, int wr, int wc, int fr, int fq) const {
        bf16_t* O = (bf16_t*)(ws + u.O); GAS float* S1 = (GAS float*)(ws + u.S1); const float* X = x + u.G;
        int ln_; asm volatile("v_mbcnt_lo_u32_b32 %0, -1, 0\n\tv_mbcnt_hi_u32_b32 %0, -1, %0" : "=v"(ln_)); (void)fr; (void)fq; const int r0 = wr * 64 + (ln_ & 15), c0 = wc * 32 + 8 * (ln_ >> 4);
#pragma unroll
        for (int ai = 0; ai < 2; ++ai) {
            f32x4 xv[4][2][2];
#pragma unroll
            for (int m = 0; m < 4; ++m)
#pragma unroll
                for (int bj = 0; bj < 2; ++bj) { const int off = (r0 + ai * 128 + m * 16) * 1024 + bj * 128 + c0; xv[m][bj][0] = *(const GAS f32x4*)(X + off); xv[m][bj][1] = *(const GAS f32x4*)(X + off + 4); }
#pragma unroll
            for (int m = 0; m < 4; ++m) { const int row = r0 + ai * 128 + m * 16; float q = 0.f;
#pragma unroll
                for (int bj = 0; bj < 2; ++bj) { const int off = row * 1024 + bj * 128 + c0;
                    const f32x4 v0 = acc[ai][bj][m][0] + xv[m][bj][0], v1 = acc[ai][bj][m][1] + xv[m][bj][1];
                    *(GAS u32x4*)(O + off) = pg8::pack8(v0, v1);
                    q += (v0[0] * v0[0] + v0[1] * v0[1]) + (v0[2] * v0[2] + v0[3] * v0[3]) + (v1[0] * v1[0] + v1[1] * v1[1]) + (v1[2] * v1[2] + v1[3] * v1[3]); }
                q += __shfl_xor(q, 16); q += __shfl_xor(q, 32);
                if (fq == 0) S1[row * 16 + wc] = q; }
        }
    }
};
struct EpiSwiglu {
    static constexpr bool CHAIN = false;
    unsigned char* ws;
    __device__ __forceinline__ void operator()(const Acc& acc, const Unit& u, int wr, int wc, int fr, int fq) const {
        bf16_t* O = (bf16_t*)(ws + u.O); const float* Gs = (const float*)(ws + u.G);
        int ln_; asm volatile("v_mbcnt_lo_u32_b32 %0, -1, 0\n\tv_mbcnt_hi_u32_b32 %0, -1, %0" : "=v"(ln_)); (void)fr; (void)fq; const int r0 = wr * 64 + (ln_ & 15), c0 = wc * 32 + 8 * (ln_ >> 4);
        f32x4 pp[2][4];
#pragma unroll
        for (int ai = 0; ai < 2; ++ai)
#pragma unroll
            for (int m = 0; m < 4; ++m) pp[ai][m] = *(const GAS f32x4*)(Gs + (r0 + ai * 128 + m * 16) * 16 + 4 * (ln_ >> 4));
#pragma unroll
        for (int ai = 0; ai < 2; ++ai)
#pragma unroll
            for (int m = 0; m < 4; ++m) { const int row = r0 + ai * 128 + m * 16;
                float sq = (pp[ai][m][0] + pp[ai][m][1]) + (pp[ai][m][2] + pp[ai][m][3]);
                sq += __shfl_xor(sq, 16); sq += __shfl_xor(sq, 32);
                const float rs = __builtin_amdgcn_rsqf(sq * (1.f / 1024.f) + EPS);
                f32x4 o[2];
#pragma unroll
                for (int n = 0; n < 2; ++n)
#pragma unroll
                    for (int j = 0; j < 4; ++j) { const float g = acc[ai][0][m][n][j] * rs, up = acc[ai][1][m][n][j] * rs; o[n][j] = g * sigmoidf_(g) * up; }
                *(GAS u32x4*)(O + row * DFF + c0) = pg8::pack8(o[0], o[1]); }
    }
};
struct EpiRes2 {
    static constexpr bool CHAIN = false;
    unsigned char* ws; float* out;
    __device__ __forceinline__ void operator()(const Acc& acc, const Unit& u, int wr, int wc, int fr, int fq) const {
        float* OUT = out + u.G; const bf16_t* XB = (const bf16_t*)(ws + u.O);
        int ln_; asm volatile("v_mbcnt_lo_u32_b32 %0, -1, 0\n\tv_mbcnt_hi_u32_b32 %0, -1, %0" : "=v"(ln_)); (void)fr; (void)fq; const int r0 = wr * 64 + (ln_ & 15), c0 = wc * 32 + 8 * (ln_ >> 4);
#pragma unroll
        for (int ai = 0; ai < 2; ++ai) {
            u32x4 xv[4][2];
#pragma unroll
            for (int m = 0; m < 4; ++m)
#pragma unroll
                for (int bj = 0; bj < 2; ++bj) xv[m][bj] = *(const GAS u32x4*)(XB + (r0 + ai * 128 + m * 16) * 1024 + bj * 128 + c0);
#pragma unroll
            for (int m = 0; m < 4; ++m)
#pragma unroll
                for (int bj = 0; bj < 2; ++bj) { const int off = (r0 + ai * 128 + m * 16) * 1024 + bj * 128 + c0; const u32x4 xb = xv[m][bj];
                    f32x4 v0 = acc[ai][bj][m][0], v1 = acc[ai][bj][m][1];
                    v0[0] += bflo(xb.x); v0[1] += bfhi(xb.x); v0[2] += bflo(xb.y); v0[3] += bfhi(xb.y); v1[0] += bflo(xb.z); v1[1] += bfhi(xb.z); v1[2] += bflo(xb.w); v1[3] += bfhi(xb.w);
                    *(GAS f32x4*)(OUT + off) = v0; *(GAS f32x4*)(OUT + off + 4) = v1; }
        }
    }
};

constexpr unsigned U(size_t v) { return (unsigned)v; }
struct Sched1 {
    int chunk, G, c, total;
    __device__ __forceinline__ bool next(int i, Unit& u) const {
        const int L = i * G + c; if (L >= total) return false;
        int w = pg8::xcd_remap(L, total); int pm, pn;
        const unsigned hoff = U(WS_H) + (unsigned)chunk * (TC * D * 2);
        u.S1 = pg8::NONE; u.G = pg8::NONE; u.G2 = pg8::NONE;
        if (w < 64 * NZT) {
            pg8::tile_order(w, 64, NZT, pm, pn);
            u.A = hoff + (unsigned)pm * (256 * D * 2); u.B = U(WS_WZ) + (unsigned)pn * (256 * D * 2);
            const unsigned rowoff = (unsigned)pm * 256;
            if (pn < 4) { u.mode = 0; u.ldc = 1024; u.O = U(WS_CB) + rowoff * 2048 + pn * 512; }
            else if (pn < 12) { u.mode = 2; u.ldc = 1024; u.O = U(WS_U) + rowoff * 2048 + (pn - 4) * 256; }
            else if (pn < 16) { u.mode = 3; u.ldc = 1024; u.O = U(WS_FQ) + rowoff * 2048 + (pn - 12) * 512; u.S1 = U(WS_SSQQ) + rowoff * 128 + (pn - 12) * 32; }
            else if (pn < 20) { u.mode = 3; u.ldc = 1024; u.O = U(WS_FK) + rowoff * 2048 + (pn - 16) * 512; u.S1 = U(WS_SSQK) + rowoff * 128 + (pn - 16) * 32; u.G = U(WS_SMALL); }
            else if (pn < 24) { u.mode = 4; u.ldc = 1024; u.O = U(WS_XQ) + rowoff * 2048 + (pn - 20) * 512; u.S1 = U(WS_SSQX) + rowoff * 64 + (pn - 20) * 16; }
            else { u.mode = 5; u.ldc = 3072; u.O = U(WS_GATES) + rowoff * 3072 + (pn - 24) * 256; }
            return true;
        }
        w -= 64 * NZT;
        if (w < 256) {
            pg8::tile_order(w, 4, 64, pm, pn);
            u.A = U(WS_WV) + (unsigned)pm * (256 * D * 2); u.B = hoff + (unsigned)pn * (256 * D * 2);
            u.mode = 0; u.ldc = TC; u.O = U(WS_VT) + (unsigned)pm * (256 * TC * 2) + pn * 512;
            return true;
        }
        w -= 256;
        if (w < 64) {
            pg8::tile_order(w, 16, 4, pm, pn);
            u.A = U(WS_MEMN) + (unsigned)pm * (256 * D * 2); u.B = U(WS_WKK) + (unsigned)pn * (256 * D * 2);
            u.mode = 4; u.ldc = 1024; u.O = U(WS_KMEM) + (unsigned)pm * (256 * 2048) + pn * 512; u.S1 = U(WS_SSQKM) + (unsigned)pm * (256 * 64) + pn * 16; u.G = U(WS_SMALL) + 512;
            return true;
        }
        w -= 64;
        pg8::tile_order(w, 4, 16, pm, pn);
        u.A = U(WS_WKV) + (unsigned)pm * (256 * D * 2); u.B = U(WS_MEMN) + (unsigned)pn * (256 * D * 2);
        u.mode = 0; u.ldc = 4096; u.O = U(WS_VTMEM) + (unsigned)pm * (256 * 4096 * 2) + pn * 512;
        return true;
    }
};
template <bool PV> struct SchedX {
    int chunk, G, c;
    __device__ __forceinline__ bool next(int i, Unit& u) const {
        const int L = i * G + c; if (L >= 256) return false;
        const unsigned hx = L & 3, qt = (L >> 2) & 7, bl = L >> 5; const unsigned bg = chunk * BC + bl; const unsigned row0 = bl * SEQ + qt * 256;
        u.mode = 0; u.ldc = 1024; u.G2 = pg8::NONE; u.S1 = pg8::NONE;
        if (!PV) {
            u.A = U(WS_XQ) + row0 * 2048 + hx * 512; u.B = U(WS_KMEM) + bg * (NMEM * 2048) + hx * 512;
            u.O = U(WS_P) + row0 * 2048 + hx * 512; u.S1 = U(WS_LSUM) + row0 * 64 + hx * 16;
            u.G = U(WS_SSQX) + row0 * 64 + hx * 16; u.G2 = U(WS_SSQKM) + bg * (NMEM * 64) + hx * 16;
        } else {
            u.A = U(WS_P) + row0 * 2048 + hx * 512; u.B = U(WS_VTMEM) + hx * (256 * 4096 * 2) + bg * (NMEM * 2);
            u.O = U(WS_XQ) + row0 * 2048 + hx * 512; u.G = U(WS_LSUM) + row0 * 64 + hx * 16;
        }
        return true;
    }
};
struct Sched3 {
    int chunk, G, c;
    __device__ __forceinline__ bool next(int i, Unit& u) const {
        const int tile = (i / 3) * G + c, br = i % 3; if (tile >= 256) return false;
        const unsigned xq_ = tile & 7, jq_ = tile >> 3; const unsigned pm = 8 * xq_ + (jq_ & 7), pn = jq_ >> 3; const unsigned row0 = pm * 256;
        const unsigned abuf = br == 0 ? U(WS_CB) : (br == 1 ? U(WS_FQ) : U(WS_XQ));
        u.A = abuf + row0 * 2048; u.B = U(WS_WBR) + (unsigned)br * (D * D * 2) + pn * (256 * D * 2);
        u.O = U(WS_H) + ((unsigned)chunk * TC + row0) * 2048 + pn * 512;
        u.G = U(WS_GATES) + row0 * 3072 + br * 1024 + pn * 256;
        u.mode = br; u.ldc = 1024; u.S1 = pg8::NONE; u.G2 = pg8::NONE;
        return true;
    }
};
template <int WHICH> struct SchedF {
    int G, c;
    __device__ __forceinline__ bool next(int i, Unit& u) const {
        constexpr int nM = T / 256, nN = (WHICH == 5) ? 22 : 4, total = nM * nN;
        const int L = i * G + c; if (L >= total) return false;
        int pm, pn; pg8::tile_order(pg8::xcd_remap(L, total), nM, nN, pm, pn);
        const unsigned row0 = (unsigned)pm * 256;
        u.mode = 0; u.ldc = 1024; u.S1 = pg8::NONE; u.G = pg8::NONE; u.G2 = pg8::NONE; u.O = pg8::NONE;
        if (WHICH == 4) {
            u.A = U(WS_H) + row0 * 2048; u.B = U(WS_WO) + (unsigned)pn * (256 * D * 2);
            u.O = U(WS_X1B) + row0 * 2048 + pn * 512; u.S1 = U(WS_SSQ2) + row0 * 64 + pn * 16;
            u.G = row0 * 1024 + pn * 256;
        } else if (WHICH == 5) {
            u.A = U(WS_X1B) + row0 * 2048; u.B = U(WS_WFI) + (unsigned)pn * (256 * D * 2);
            u.O = U(WS_ACT) + row0 * (DFF * 2) + pn * 256; u.G = U(WS_SSQ2) + row0 * 64;
        } else {
            u.A = U(WS_ACT) + row0 * (DFF * 2); u.B = U(WS_WFO) + (unsigned)pn * (256 * DFF * 2);
            u.O = U(WS_X1B) + row0 * 2048 + pn * 512;
            u.G = row0 * 1024 + pn * 256;
        }
        return true;
    }
};

__device__ __forceinline__ void tr_item(const float* W, int ldw, int srccol, int k0, bf16_t* WT, int K, int drow, const float* kscale, LAS float* scr, int lane) {
    float tv[32];
#pragma unroll
    for (int i = 0; i < 32; ++i) { const int kk = 2 * i + (lane >> 5); tv[i] = __builtin_nontemporal_load((const GAS float*)W + ((size_t)(k0 + kk) * ldw + srccol + (lane & 31))); }
    if (kscale) {
#pragma unroll
        for (int i = 0; i < 32; ++i) tv[i] *= ((const GAS float*)kscale)[k0 + 2 * i + (lane >> 5)]; }
#pragma unroll
    for (int i = 0; i < 32; ++i) scr[(2 * i + (lane >> 5)) * 33 + (lane & 31)] = tv[i];
    LDS_WAIT();
    const int c = lane & 7;
#pragma unroll
    for (int j = 0; j < 4; ++j) { const int n = (lane >> 3) + 8 * j; const LAS float* s = scr + (8 * c) * 33 + n;
        u32x4 o; o.x = cvt_pk(s[0 * 33], s[1 * 33]); o.y = cvt_pk(s[2 * 33], s[3 * 33]); o.z = cvt_pk(s[4 * 33], s[5 * 33]); o.w = cvt_pk(s[6 * 33], s[7 * 33]);
        *(GAS u32x4*)(WT + (size_t)(drow + n) * K + k0 + 8 * c) = o; }
    LDS_WAIT();
}
__device__ __forceinline__ int zsrc(int np) { const int tj = np >> 8, o = np & 255;
    if (tj < 4) return np;
    if (tj < 12) { const int j = tj - 4; return (o < 128) ? 1024 + 128 * j + o : 2048 + 128 * j + (o - 128); }
    if (tj < 16) return 3072 + (np - 12 * 256);
    if (tj < 20) return 4096 + (np - 16 * 256);
    if (tj < 24) return 6144 + (np - 20 * 256);
    return 7168 + (np - 24 * 256); }
__device__ __forceinline__ int fsrc(int np) { const int tj = np >> 8, o = np & 255; return (o < 128) ? 128 * tj + o : DFF + 128 * tj + (o - 128); }

constexpr int TR_NA = 16 * 288 + 3 * 512, TR_NITEMS = 16 * 288 + 7 * 512 + 16 * 176 + 44 * 32;
__device__ __forceinline__ void tr_items(const Args& a, unsigned char* ws, LAS float* scr, int lane, int lo, int hi, int gw, int NGW) {
    constexpr int I0 = 16 * 288, I1 = 512, I9 = 44 * 32, I8 = 16 * 176;
    for (int it = lo + gw; it < hi; it += NGW) {
        int r = it;
        if (r < I0) { const int kb = r / 288, nb = r % 288; tr_item(a.w_in, INCOLS, zsrc(32 * nb), 64 * kb, (bf16_t*)(ws + WS_WZ), D, 32 * nb, nullptr, scr, lane); continue; } r -= I0;
        if (r < I1) { const int kb = r / 32, nb = r % 32; tr_item(a.w_in, INCOLS, 5120 + 32 * nb, 64 * kb, (bf16_t*)(ws + WS_WV), D, 32 * nb, nullptr, scr, lane); continue; } r -= I1;
        if (r < I1) { const int kb = r / 32, nb = r % 32; tr_item(a.w_mem_kv, 2048, 32 * nb, 64 * kb, (bf16_t*)(ws + WS_WKK), D, 32 * nb, nullptr, scr, lane); continue; } r -= I1;
        if (r < I1) { const int kb = r / 32, nb = r % 32; tr_item(a.w_mem_kv, 2048, 1024 + 32 * nb, 64 * kb, (bf16_t*)(ws + WS_WKV), D, 32 * nb, nullptr, scr, lane); continue; } r -= I1;
        if (r < I1) { const int kb = r / 32, nb = r % 32; tr_item(a.w_br_conv, D, 32 * nb, 64 * kb, (bf16_t*)(ws + WS_WBR), D, 32 * nb, nullptr, scr, lane); continue; } r -= I1;
        if (r < I1) { const int kb = r / 32, nb = r % 32; tr_item(a.w_br_fox, D, 32 * nb, 64 * kb, (bf16_t*)(ws + WS_WBR) + (size_t)D * D, D, 32 * nb, nullptr, scr, lane); continue; } r -= I1;
        if (r < I1) { const int kb = r / 32, nb = r % 32; tr_item(a.w_br_xa, D, 32 * nb, 64 * kb, (bf16_t*)(ws + WS_WBR) + (size_t)2 * D * D, D, 32 * nb, nullptr, scr, lane); continue; } r -= I1;
        if (r < I1) { const int kb = r / 32, nb = r % 32; tr_item(a.w_o, D, 32 * nb, 64 * kb, (bf16_t*)(ws + WS_WO), D, 32 * nb, nullptr, scr, lane); continue; } r -= I1;
        if (r < I8) { const int kb = r / 176, nb = r % 176; tr_item(a.w_ffn_in, 2 * DFF, fsrc(32 * nb), 64 * kb, (bf16_t*)(ws + WS_WFI), D, 32 * nb, a.norm2_g, scr, lane); continue; } r -= I8;
        { const int kb = r / 32, nb = r % 32; tr_item(a.w_ffn_out, D, 32 * nb, 64 * kb, (bf16_t*)(ws + WS_WFO), DFF, 32 * nb, nullptr, scr, lane); }
    }
}
__device__ __forceinline__ void p0_prologue(const Args& a, LAS unsigned char* lds, int G) {
    unsigned char* ws = a.ws;
    int tid = threadIdx.x; asm volatile("" : "+v"(tid));
    const int lane = tid & 63, wave = tid >> 6;
    LAS float* scr = (LAS float*)(lds + wave * 8704);
    LAS float* wff = (LAS float*)(lds + 81920);
    for (int idx = tid; idx < 8192; idx += 512) { const int o = idx & 3, l = (idx >> 2) & 63, je = (idx >> 8) & 15, half = idx >> 12;
        const int k = 256 * (je >> 2) + 4 * l + (je & 3); wff[idx] = ((const GAS float*)a.norm1_g)[k] * ((const GAS float*)a.w_in)[(size_t)k * INCOLS + 10240 + 4 * half + o]; }
    if (blockIdx.x == 0) { float* sm = (float*)(ws + WS_SMALL);
        if (tid < 128) sm[tid] = a.fox_q_g[tid] * a.fox_k_g[tid];
        if (tid < 256) sm[128 + tid] = a.xa_q_g[tid] * a.xa_k_g[tid]; }
    __syncthreads();
    const int gw = blockIdx.x * 8 + wave, NGW = G * 8;
    tr_items(a, ws, scr, lane, 0, TR_NA, gw, NGW);
    f32x4 g1[4], gm[4];
#pragma unroll
    for (int j = 0; j < 4; ++j) { g1[j] = *(const GAS f32x4*)(a.norm1_g + 256 * j + 4 * lane); gm[j] = *(const GAS f32x4*)(a.mem_norm_g + 256 * j + 4 * lane); }
    for (int m0 = gw; m0 < T + NBATCH * NMEM; m0 += 2 * NGW) {
        f32x4 v2[2][4]; const int m1 = m0 + NGW; const bool has1 = m1 < T + NBATCH * NMEM;
#pragma unroll
        for (int rr = 0; rr < 2; ++rr) { const int m = rr ? (has1 ? m1 : m0) : m0; const float* xr = (m < T) ? a.x + (size_t)m * D : a.mem + (size_t)(m - T) * D;
#pragma unroll
            for (int j = 0; j < 4; ++j) v2[rr][j] = __builtin_nontemporal_load((const GAS f32x4*)(xr + 256 * j + 4 * lane)); }
#pragma unroll
        for (int rr = 0; rr < 2; ++rr) {
            if (rr == 1 && !has1) break;
            const int m = rr ? m1 : m0;
            const bool isx = m < T;
            bf16_t* orow = isx ? (bf16_t*)(ws + WS_H) + (size_t)m * D : (bf16_t*)(ws + WS_MEMN) + (size_t)(m - T) * D;
            f32x4 v[4]; float s = 0.f;
#pragma unroll
            for (int j = 0; j < 4; ++j) { v[j] = v2[rr][j]; s += (v[j][0] * v[j][0] + v[j][1] * v[j][1]) + (v[j][2] * v[j][2] + v[j][3] * v[j][3]); }
            const float rstd = 1.f / sqrtf(wave_sum(s) * (1.f / D) + EPS);
#pragma unroll
            for (int j = 0; j < 4; ++j) { const f32x4 gg = isx ? g1[j] : gm[j]; const f32x4 o = v[j] * rstd * gg;
                *(GAS u32x2*)(orow + 256 * j + 4 * lane) = (u32x2){cvt_pk(o[0], o[1]), cvt_pk(o[2], o[3])}; }
            if (isx) {
                f32x4 fa = {0.f, 0.f, 0.f, 0.f}, fb = {0.f, 0.f, 0.f, 0.f};
#pragma unroll
                for (int j = 0; j < 4; ++j)
#pragma unroll
                    for (int e = 0; e < 4; ++e) { const int je = j * 4 + e; const f32x4 wa = *(const LAS f32x4*)(wff + (je * 64 + lane) * 4), wb = *(const LAS f32x4*)(wff + ((16 + je) * 64 + lane) * 4);
                        fa += wa * v[j][e]; fb += wb * v[j][e]; }
                float tot[8];
#pragma unroll
                for (int o = 0; o < 4; ++o) { tot[o] = wave_sum(fa[o]); tot[4 + o] = wave_sum(fb[o]); }
                float mine = tot[0];
#pragma unroll
                for (int o = 1; o < 8; ++o) mine = (lane == o) ? tot[o] : mine;
                if (lane < 8) { const float z = mine * rstd + ((const GAS float*)a.fox_f_bias)[lane];
                    const float ls = fminf(z, 0.f) - log1pf(expf(-fabsf(z)));
                    ((GAS float*)(ws + WS_LOGF))[(size_t)m * 8 + lane] = ls; }
            }
        }
    }
}

__device__ __forceinline__ void cumsum_bh(unsigned char* ws, int b, int h, int lane) {
    asm volatile("" : "+v"(lane));
    const GAS float* lf = (const GAS float*)(ws + WS_LOGF) + ((size_t)b * SEQ + 32 * lane) * 8 + h;
    float v[32]; float run = 0.f;
#pragma unroll
    for (int i = 0; i < 32; ++i) { run += lf[i * 8]; v[i] = run; }
    float incl = run;
#pragma unroll
    for (int o = 1; o < 64; o <<= 1) { const float t = __shfl_up(incl, o); if (lane >= o) incl += t; }
    const float base = incl - run;
    GAS float* c2 = (GAS float*)(ws + WS_C2) + ((size_t)(b * NH + h)) * SEQ + 32 * lane;
#pragma unroll
    for (int i = 0; i < 8; ++i) *(GAS f32x4*)(c2 + 4 * i) = (f32x4){(v[4 * i] + base) * LOG2E, (v[4 * i + 1] + base) * LOG2E, (v[4 * i + 2] + base) * LOG2E, (v[4 * i + 3] + base) * LOG2E};
}

__device__ __forceinline__ void conv_item(unsigned char* ws, const float* conv_w, const float* conv_b, int item, int tid) {
    asm volatile("" : "+v"(tid));
    const int cgp = tid & 127, tr = tid >> 7; const int ch = 8 * cgp; const int t0 = item * 32 + tr * 8;
    bf16_t* cb = (bf16_t*)(ws + WS_CB); const bf16_t* ub = (const bf16_t*)(ws + WS_U);
    float w0[8], w1[8], w2[8], bb[8];
#pragma unroll
    for (int j = 0; j < 8; ++j) { w0[j] = ((const GAS float*)conv_w)[ch + j]; w1[j] = ((const GAS float*)conv_w)[D + ch + j]; w2[j] = ((const GAS float*)conv_w)[2 * D + ch + j]; bb[j] = ((const GAS float*)conv_b)[ch + j]; }
    float um2[8], um1[8];
    const bool first = (t0 % SEQ) == 0;
    { u32x4 p2 = {0u, 0u, 0u, 0u}, p1 = {0u, 0u, 0u, 0u};
      if (!first) { p2 = *(const GAS u32x4*)(ub + (size_t)(t0 - 2) * D + ch); p1 = *(const GAS u32x4*)(ub + (size_t)(t0 - 1) * D + ch); }
      um2[0] = bflo(p2.x); um2[1] = bfhi(p2.x); um2[2] = bflo(p2.y); um2[3] = bfhi(p2.y); um2[4] = bflo(p2.z); um2[5] = bfhi(p2.z); um2[6] = bflo(p2.w); um2[7] = bfhi(p2.w);
      um1[0] = bflo(p1.x); um1[1] = bfhi(p1.x); um1[2] = bflo(p1.y); um1[3] = bfhi(p1.y); um1[4] = bflo(p1.z); um1[5] = bfhi(p1.z); um1[6] = bflo(p1.w); um1[7] = bfhi(p1.w); }
    u32x4 pu[8], pc[8];
#pragma unroll
    for (int i = 0; i < 8; ++i) { pu[i] = *(const GAS u32x4*)(ub + (size_t)(t0 + i) * D + ch); pc[i] = *(const GAS u32x4*)(cb + (size_t)(t0 + i) * D + ch); }
#pragma unroll
    for (int i = 0; i < 8; ++i) {
        float uu[8], cc[8], y[8];
        uu[0] = bflo(pu[i].x); uu[1] = bfhi(pu[i].x); uu[2] = bflo(pu[i].y); uu[3] = bfhi(pu[i].y); uu[4] = bflo(pu[i].z); uu[5] = bfhi(pu[i].z); uu[6] = bflo(pu[i].w); uu[7] = bfhi(pu[i].w);
        cc[0] = bflo(pc[i].x); cc[1] = bfhi(pc[i].x); cc[2] = bflo(pc[i].y); cc[3] = bfhi(pc[i].y); cc[4] = bflo(pc[i].z); cc[5] = bfhi(pc[i].z); cc[6] = bflo(pc[i].w); cc[7] = bfhi(pc[i].w);
#pragma unroll
        for (int j = 0; j < 8; ++j) { y[j] = cc[j] * (w0[j] * um2[j] + w1[j] * um1[j] + w2[j] * uu[j] + bb[j]); um2[j] = um1[j]; um1[j] = uu[j]; }
        *(GAS u32x4*)(cb + (size_t)(t0 + i) * D + ch) = (u32x4){cvt_pk(y[0], y[1]), cvt_pk(y[2], y[3]), cvt_pk(y[4], y[5]), cvt_pk(y[6], y[7])};
    }
}

constexpr int FX_KP = 272, FX_VP = 144, FX_KOFF = 0, FX_VOFF = 64 * FX_KP, FX_COFF = FX_VOFF + 128 * FX_VP, FX_STG = FX_COFF + 256;
__device__ __forceinline__ void fox_unit(LAS unsigned char* lds, unsigned char* ws, int bl, int bg, int h, int qblk) {
    int tid = threadIdx.x; asm volatile("" : "+v"(tid));
    const int lane = tid & 63, wave = __builtin_amdgcn_readfirstlane(tid >> 6), ql = lane & 31, hi = lane >> 5;
    const GAS bf16_t* FQ = (const GAS bf16_t*)(ws + WS_FQ); const GAS bf16_t* FK = (const GAS bf16_t*)(ws + WS_FK); const GAS bf16_t* VT = (const GAS bf16_t*)(ws + WS_VT);
    const GAS float* ssqq = (const GAS float*)(ws + WS_SSQQ); const GAS float* ssqk = (const GAS float*)(ws + WS_SSQK);
    const GAS float* c2 = (const GAS float*)(ws + WS_C2) + (size_t)(bg * NH + h) * SEQ;
    const int q0 = qblk * 256 + 32 * wave, qa = q0 + ql;
    const size_t qrow = (size_t)bl * SEQ + qa;
    bf16x8 qf[8];
    { const f32x4 p = *(const GAS f32x4*)(ssqq + qrow * 32 + 4 * h);
      const float sc = __builtin_amdgcn_rsqf(((p[0] + p[1]) + (p[2] + p[3])) * (1.f / 128.f) + EPS) * (LOG2E * 0.08838834764831845f);
#pragma unroll
      for (int ds = 0; ds < 8; ++ds) { const u32x4 r = *(const GAS u32x4*)(FQ + qrow * 1024 + h * 128 + 16 * ds + 8 * hi);
          u32x4 o; o.x = cvt_pk(bflo(r.x) * sc, bfhi(r.x) * sc); o.y = cvt_pk(bflo(r.y) * sc, bfhi(r.y) * sc); o.z = cvt_pk(bflo(r.z) * sc, bfhi(r.z) * sc); o.w = cvt_pk(bflo(r.w) * sc, bfhi(r.w) * sc);
          qf[ds] = __builtin_bit_cast(bf16x8, o); } }
    f32x16 ot[4];
#pragma unroll
    for (int i = 0; i < 4; ++i)
#pragma unroll
        for (int r = 0; r < 16; ++r) ot[i][r] = 0.f;
    float mrun = -1e30f, lrun = 0.f;
    const int nkt = qblk * 4 + 4, kt_diag = q0 >> 6;
    const int krow = tid >> 3, kpc = tid & 7, vrow = tid >> 2, vpc = tid & 3;
    u32x4 kr0, kr1, vr0, vr1; f32x4 kss; float ckv = 0.f;
#define FX_GLOAD(kt_) do { const int s0_ = (kt_) * 64; const size_t kr_ = (size_t)bl * SEQ + s0_ + krow; \
        const GAS bf16_t* kp_ = FK + kr_ * 1024 + h * 128 + 16 * kpc; kr0 = *(const GAS u32x4*)kp_; kr1 = *(const GAS u32x4*)(kp_ + 8); kss = *(const GAS f32x4*)(ssqk + kr_ * 32 + 4 * h); \
        const GAS bf16_t* vp_ = VT + (size_t)(h * 128 + vrow) * TC + (size_t)bl * SEQ + s0_ + 16 * vpc; vr0 = *(const GAS u32x4*)vp_; vr1 = *(const GAS u32x4*)(vp_ + 8); \
        if (tid < 64) ckv = c2[s0_ + tid]; } while (0)
#define FX_SCALE2(w_, rk_) cvt_pk(bflo(w_) * (rk_), bfhi(w_) * (rk_))
#define FX_LSTORE(stg_) do { LAS unsigned char* sb_ = lds + (stg_) * FX_STG; \
        const float rk_ = __builtin_amdgcn_rsqf(((kss[0] + kss[1]) + (kss[2] + kss[3])) * (1.f / 128.f) + EPS); \
        u32x4 a_, b_; a_.x = FX_SCALE2(kr0.x, rk_); a_.y = FX_SCALE2(kr0.y, rk_); a_.z = FX_SCALE2(kr0.z, rk_); a_.w = FX_SCALE2(kr0.w, rk_); \
        b_.x = FX_SCALE2(kr1.x, rk_); b_.y = FX_SCALE2(kr1.y, rk_); b_.z = FX_SCALE2(kr1.z, rk_); b_.w = FX_SCALE2(kr1.w, rk_); \
        *(LAS u32x4*)(sb_ + FX_KOFF + krow * FX_KP + kpc * 32) = a_; *(LAS u32x4*)(sb_ + FX_KOFF + krow * FX_KP + kpc * 32 + 16) = b_; \
        LAS unsigned char* vd_ = sb_ + FX_VOFF + vrow * FX_VP + vpc * 32; \
        *(LAS u32x4*)(vd_) = (u32x4){vr0.x, vr0.y, vr1.x, vr1.y}; *(LAS u32x4*)(vd_ + 16) = (u32x4){vr0.z, vr0.w, vr1.z, vr1.w};   \
        if (tid < 64) *(LAS float*)(sb_ + FX_COFF + tid * 4) = ckv; } while (0)
    FX_GLOAD(nkt - 1); FX_LSTORE(0); FX_GLOAD(nkt - 2);
    __syncthreads();
    for (int it = 0; it < nkt; ++it) {
        const int kt = nkt - 1 - it;
        if (it + 1 < nkt) FX_LSTORE((it + 1) & 1);
        if (it + 2 < nkt) FX_GLOAD(kt - 2);
        if (kt <= kt_diag) {
            LAS unsigned char* sb = lds + (it & 1) * FX_STG;
            const LAS float* cks = (const LAS float*)(sb + FX_COFF);
            f32x16 s0, s1;
#pragma unroll
            for (int g = 0; g < 4; ++g) { const f32x4 c0 = *(const LAS f32x4*)(cks + 8 * g + 4 * hi), c1 = *(const LAS f32x4*)(cks + 32 + 8 * g + 4 * hi);
#pragma unroll
                for (int e = 0; e < 4; ++e) { s0[4 * g + e] = -c0[e]; s1[4 * g + e] = -c1[e]; } }
            const LAS unsigned char* kb0 = sb + FX_KOFF + ql * FX_KP + hi * 16;
#pragma unroll
            for (int ds = 0; ds < 8; ++ds) { const bf16x8 a0 = *(const LAS bf16x8*)(kb0 + ds * 32), a1 = *(const LAS bf16x8*)(kb0 + 32 * FX_KP + ds * 32);
                s0 = __builtin_amdgcn_mfma_f32_32x32x16_bf16(a0, qf[ds], s0, 0, 0, 0); s1 = __builtin_amdgcn_mfma_f32_32x32x16_bf16(a1, qf[ds], s1, 0, 0, 0); }
            const int krel = qa - kt * 64;
            if (kt == kt_diag) {
#pragma unroll
                for (int r = 0; r < 16; ++r) { const int key = 8 * (r >> 2) + 4 * hi + (r & 3); if (key > krel) s0[r] = -INFINITY; if (key + 32 > krel) s1[r] = -INFINITY; }
                asm volatile("" ::: "memory");
            }
            float mloc = -INFINITY;
#pragma unroll
            for (int r = 0; r < 16; ++r) mloc = fmaxf(mloc, fmaxf(s0[r], s1[r]));
            mloc = fmaxf(mloc, __shfl_xor(mloc, 32));
            const float mnew = fmaxf(mrun, mloc), alpha = fexp2(mrun - mnew);
            float psum = 0.f;
#pragma unroll
            for (int r = 0; r < 16; ++r) { s0[r] = fexp2(s0[r] - mnew); s1[r] = fexp2(s1[r] - mnew); psum += s0[r] + s1[r]; }
            psum += __shfl_xor(psum, 32);
            lrun = lrun * alpha + psum; mrun = mnew;
            if (__builtin_amdgcn_ballot_w64(alpha != 1.0f)) {
#pragma unroll
                for (int i = 0; i < 4; ++i)
#pragma unroll
                    for (int r = 0; r < 16; ++r) ot[i][r] *= alpha;
            }
            bf16x8 pf[4];
#pragma unroll
            for (int j = 0; j < 2; ++j) {
                u32x4 a = {cvt_pk(s0[8 * j], s0[8 * j + 1]), cvt_pk(s0[8 * j + 2], s0[8 * j + 3]), cvt_pk(s0[8 * j + 4], s0[8 * j + 5]), cvt_pk(s0[8 * j + 6], s0[8 * j + 7])};
                u32x4 b = {cvt_pk(s1[8 * j], s1[8 * j + 1]), cvt_pk(s1[8 * j + 2], s1[8 * j + 3]), cvt_pk(s1[8 * j + 4], s1[8 * j + 5]), cvt_pk(s1[8 * j + 6], s1[8 * j + 7])};
                pf[j] = __builtin_bit_cast(bf16x8, a); pf[2 + j] = __builtin_bit_cast(bf16x8, b); }
            const LAS unsigned char* vb0 = sb + FX_VOFF + ql * FX_VP + hi * 16;
#pragma unroll
            for (int db = 0; db < 4; ++db)
#pragma unroll
                for (int st = 0; st < 4; ++st) { const bf16x8 vf = *(const LAS bf16x8*)(vb0 + db * 32 * FX_VP + st * 32);
                    ot[db] = __builtin_amdgcn_mfma_f32_32x32x16_bf16(vf, pf[st], ot[db], 0, 0, 0); }
        }
        __syncthreads();
    }
#undef FX_GLOAD
#undef FX_SCALE2
#undef FX_LSTORE
    const float inv = 1.f / lrun;
    GAS bf16_t* op = (GAS bf16_t*)(ws + WS_FQ) + qrow * 1024 + h * 128 + 4 * hi;
#pragma unroll
    for (int db = 0; db < 4; ++db)
#pragma unroll
        for (int g = 0; g < 4; ++g) *(GAS u32x2*)(op + 32 * db + 8 * g) = (u32x2){cvt_pk(ot[db][4 * g] * inv, ot[db][4 * g + 1] * inv), cvt_pk(ot[db][4 * g + 2] * inv, ot[db][4 * g + 3] * inv)};
}

__device__ __forceinline__ void grid_bar(unsigned char* ws, int k, int G, int tid) {
    unsigned* base = (unsigned*)(ws + WS_BAR) + k * 512;
    asm volatile("s_waitcnt vmcnt(0) lgkmcnt(0)" ::: "memory");
    __syncthreads();
    if (tid == 0) {
        const unsigned c = blockIdx.x, g = c & 7u, ng = (unsigned)G < 8u ? (unsigned)G : 8u, members = ((unsigned)G - g + 7u) >> 3;
        __builtin_amdgcn_fence(__ATOMIC_RELEASE, "agent");
        asm volatile("s_waitcnt vmcnt(0)" ::: "memory");
        const unsigned old = __hip_atomic_fetch_add(base + 32 * g, 1u, __ATOMIC_ACQ_REL, __HIP_MEMORY_SCOPE_AGENT);
        if (old + 1u == members) __hip_atomic_fetch_add(base + 256, 1u, __ATOMIC_ACQ_REL, __HIP_MEMORY_SCOPE_AGENT);
        unsigned spins = 0;
        while (__hip_atomic_load(base + 256, __ATOMIC_RELAXED, __HIP_MEMORY_SCOPE_AGENT) < ng) { __builtin_amdgcn_s_sleep(1); if (++spins > (1u << 22)) break; }
        __builtin_amdgcn_fence(__ATOMIC_ACQUIRE, "agent");
        asm volatile("s_waitcnt vmcnt(0)" ::: "memory");
    }
    __syncthreads();
}

template <unsigned PHM, bool COOP>
__global__ void __launch_bounds__(512, 2) hybrid_fwd(Args a, int ch_lo, int ch_hi) {
    __shared__ __attribute__((aligned(16))) unsigned char lds_raw[LDS_BYTES];
    LAS unsigned char* lds = (LAS unsigned char*)lds_raw;
#define PHON(k) ((PHM >> (k)) & 1u)
#define SEAM(k) do { if constexpr (COOP) { grid_bar(ws, (k), G, tid); } } while (0)
#define FRESH() unsigned char* ws = a.ws; int G = gridDim.x, c = blockIdx.x, tid = threadIdx.x; asm volatile("" : "+s"(ws)); asm volatile("" : "+s"(G)); asm volatile("" : "+s"(c)); asm volatile("" : "+v"(tid))
    if constexpr (PHON(0)) { FRESH(); (void)c; (void)tid; (void)ws; p0_prologue(a, lds, G); if constexpr (COOP) { if (G == 0x7fffffff) cg::this_grid().sync(); } SEAM(15); }

#pragma unroll 1
    for (int ch = ch_lo; ch < ch_hi; ++ch) {
        if constexpr (PHON(1)) { FRESH(); if (ch == 0) {
            const int nb_ = G >= 16 ? 16 : G, c0_ = c - (G - nb_);
            if (c0_ >= 0) for (int bh = c0_ * 8 + __builtin_amdgcn_readfirstlane(tid >> 6); bh < NBATCH * NH; bh += nb_ * 8) cumsum_bh(ws, bh >> 3, bh & 7, tid & 63); } }
        if constexpr (PHON(2)) { FRESH(); (void)tid; Sched1 S{ch, G, c, 64 * NZT + 256 + (ch == 0 ? 128 : 0)}; Epi1 E{ws};
          pg8::gemm_phase<Epi1, Sched1>(lds, (const char*)ws, D, D, D, S, E);
          if (ch == 0) { const int nb_ = G >= 2 ? G / 2 : 1, c0_ = c - (G - nb_);
            if (c0_ >= 0) { int t2 = threadIdx.x; asm volatile("" : "+v"(t2)); tr_items(a, ws, (LAS float*)(lds + (t2 >> 6) * 8704), t2 & 63, TR_NA, TR_NITEMS, c0_ * 8 + (t2 >> 6), nb_ * 8); } }
          SEAM(1 + 3 * ch); }
        if constexpr (PHON(3)) { FRESH(); (void)tid; SchedX<false> S{ch, G, c}; EpiS E{ws}; pg8::gemm_phase<EpiS, SchedX<false>>(lds, (const char*)ws, 256, 1024, 1024, S, E);
          __builtin_amdgcn_fence(__ATOMIC_ACQUIRE, "agent"); asm volatile("s_waitcnt vmcnt(0)" ::: "memory"); __syncthreads(); }
        if constexpr (PHON(6)) { FRESH(); (void)tid; SchedX<true> S{ch, G, c}; EpiPV E{ws}; pg8::gemm_phase<EpiPV, SchedX<true>>(lds, (const char*)ws, 256, 1024, 4096, S, E); }
        if constexpr (PHON(4)) { FRESH(); for (int it = c; it < TC / 32; it += G) conv_item(ws, a.conv_w, a.conv_b, it, tid); }
        if constexpr (PHON(5)) { FRESH(); (void)tid; for (int p = c; p < 256; p += G) { const int bh = 8 * (p & 7) + (p >> 5), j = (p >> 3) & 3; const int bl = bh >> 3, h = bh & 7;
            fox_unit(lds, ws, bl, ch * BC + bl, h, 7 - j); __syncthreads(); fox_unit(lds, ws, bl, ch * BC + bl, h, j); __syncthreads(); }
          SEAM(2 + 3 * ch); }
        if constexpr (PHON(7)) { FRESH(); (void)tid; Sched3 S{ch, G, c}; EpiGate E{ws}; pg8::gemm_phase<EpiGate, Sched3>(lds, (const char*)ws, D, D, D, S, E); SEAM(3 + 3 * ch); }
    }
    if constexpr (PHON(8)) { FRESH(); (void)tid; SchedF<4> S{G, c}; EpiRes1 E{ws, a.x, a.out}; pg8::gemm_phase<EpiRes1, SchedF<4>>(lds, (const char*)ws, D, D, D, S, E); SEAM(8); }
    if constexpr (PHON(9)) { FRESH(); (void)tid; SchedF<5> S{G, c}; EpiSwiglu E{ws}; pg8::gemm_phase<EpiSwiglu, SchedF<5>>(lds, (const char*)ws, D, D, D, S, E); SEAM(9); }
    if constexpr (PHON(10)) { FRESH(); (void)tid; SchedF<6> S{G, c}; EpiRes2 E{ws, a.out}; pg8::gemm_phase<EpiRes2, SchedF<6>>(lds, (const char*)ws, DFF, DFF, DFF, S, E); }
}

#ifndef N_LAUNCH_MODE
#define N_LAUNCH_MODE 1
#endif
template <unsigned PHM> static void launch_plain(const Args& a, int lo, int hi, int grid, hipStream_t stream) {
    hipLaunchKernelGGL((hybrid_fwd<PHM, false>), dim3(grid), dim3(512), 0, stream, a, lo, hi);
}

extern "C" void kernel_launch(void* const* d_in, const int* in_sizes, int n_in, void* d_out, int out_size, void* d_ws, size_t ws_size, hipStream_t stream) {
    static int grid = 0;
    if (grid == 0) {
        if (n_in != 20 || out_size != T * D || ws_size < WS_END) { fprintf(stderr, "kernel_launch: unexpected shapes (n_in %d out %d ws %zu)\n", n_in, out_size, ws_size); grid = -1; return; }
        int dev = 0, cus = 0;
        (void)hipGetDevice(&dev); (void)hipDeviceGetAttribute(&cus, hipDeviceAttributeMultiprocessorCount, dev);
        (void)hipGetLastError();
        grid = cus > 0 ? cus : 256;
    }
    if (grid < 0) return;
    Args a{};
    const float** p = (const float**)&a;
    for (int i = 0; i < 20; ++i) p[i] = (const float*)d_in[i];
    a.out = (float*)d_out; a.ws = (unsigned char*)d_ws;
#if N_LAUNCH_MODE == 1
    (void)hipMemsetAsync((unsigned char*)d_ws + WS_BAR, 0, 16 * 2048, stream);
    int lo = 0, hi = NCH;
    void* args[] = {&a, &lo, &hi};
    hipError_t e = hipLaunchCooperativeKernel((const void*)hybrid_fwd<0x7ffu, true>, dim3(grid), dim3(512), args, 0, stream);
    if (e != hipSuccess) fprintf(stderr, "cooperative launch failed: %s (grid %d)\n", hipGetErrorString(e), grid);
#else
    launch_plain<0x1u>(a, 0, 0, grid, stream);
    for (int ch = 0; ch < NCH; ++ch) {
        if (ch == 0) launch_plain<0x2u>(a, ch, ch + 1, grid, stream);
        launch_plain<0x4u>(a, ch, ch + 1, grid, stream);
        launch_plain<0x78u>(a, ch, ch + 1, grid, stream);
        launch_plain<0x80u>(a, ch, ch + 1, grid, stream);
    }
    launch_plain<0x100u>(a, 0, 0, grid, stream);
    launch_plain<0x200u>(a, 0, 0, grid, stream);
    launch_plain<0x400u>(a, 0, 0, grid, stream);
#endif
}
```
